# Optimizing an MI355X kernel written in HIP

```python
import math
import jax, jax.numpy as jnp
from jax import lax
import numpy as np

D_MODEL = 4096
BATCH = 1
SEQ = 8192
DEPTH = 2

HEAD_DIM = 128
SSM_CHANNELS = D_MODEL // 4
N_ATTN_HEADS = (D_MODEL - SSM_CHANNELS) // HEAD_DIM
N_SB_HEADS = N_ATTN_HEADS // 2
N_DIL_HEADS = N_ATTN_HEADS - N_SB_HEADS
SB_WIDTH = N_SB_HEADS * HEAD_DIM
DIL_WIDTH = N_DIL_HEADS * HEAD_DIM
MIX_WIDTH = SB_WIDTH + DIL_WIDTH + SSM_CHANNELS
SSM_GROUP = 16
N_SSM_GROUPS = SSM_CHANNELS // SSM_GROUP
SSM_STATE = 64
IN_WIDTH = 3 * SB_WIDTH + 3 * DIL_WIDTH + SSM_CHANNELS
FFN_HIDDEN = -(-8 * D_MODEL // (3 * 256)) * 256
SB_BLOCK = 128
DIL_BLOCK = 128
DIL_PATTERNS = ((128, 1), (512, 4), (2048, 16))
RMS_EPS = 1e-6

kernel_name = "hybrid_sb_dilated_s5_block"


def rms_norm(x, g):
    xf = x.astype(jnp.float32)
    y = xf * lax.rsqrt(jnp.mean(xf * xf, axis=-1, keepdims=True) + RMS_EPS)
    return (y * g.astype(jnp.float32)).astype(x.dtype)


def stick_breaking_attention(q, k, v):
    b, L, h, dh = q.shape
    nb = L // SB_BLOCK
    scale = dh ** -0.5
    kf = k.astype(jnp.float32)
    vf = v.astype(jnp.float32)
    qb = jnp.moveaxis(q.astype(jnp.float32).reshape(b, nb, SB_BLOCK, h, dh), 1, 0)
    key_pos = jnp.arange(L)

    def one_block(args):
        qi, blk = args
        q_pos = blk * SB_BLOCK + jnp.arange(SB_BLOCK)
        z = jnp.einsum('bqhd,bkhd->bhqk', qi, kf) * scale
        causal = key_pos[None, :] < q_pos[:, None]
        log_1m_beta = jnp.where(causal, -jax.nn.softplus(z), 0.0)
        suffix = lax.cumsum(log_1m_beta, axis=3, reverse=True)
        excl = jnp.concatenate([suffix[..., 1:], jnp.zeros_like(suffix[..., :1])], axis=-1)
        log_a = jax.nn.log_sigmoid(z) + excl
        a = jnp.where(causal, jnp.exp(log_a), 0.0)
        return jnp.einsum('bhqk,bkhd->bqhd', a, vf)

    out = lax.map(one_block, (qb, jnp.arange(nb)))
    return jnp.moveaxis(out, 0, 1).reshape(b, L, h, dh)


def dilated_branch(q, k, v, window, dilation):
    b, L, h, dh = q.shape
    scale = dh ** -0.5
    span = dilation * DIL_BLOCK
    L_pad = -(-L // span) * span
    Ls = L_pad // dilation
    nb = Ls // DIL_BLOCK
    n_back = window // dilation

    def to_sub(x):
        x = jnp.pad(x.astype(jnp.float32), ((0, 0), (0, L_pad - L), (0, 0), (0, 0)))
        x = jnp.moveaxis(x.reshape(b, Ls, dilation, h, dh), 2, 1)
        return x.reshape(b, dilation, nb, DIL_BLOCK, h, dh)

    def with_prev(x):
        prev = jnp.pad(x, ((0, 0), (0, 0), (1, 0), (0, 0), (0, 0), (0, 0)))[:, :, :-1]
        return jnp.concatenate([prev, x], axis=3)

    qs = to_sub(q)
    kk = with_prev(to_sub(k))
    vv = with_prev(to_sub(v))
    scores = jnp.einsum('brnqhd,brnkhd->brnhqk', qs, kk) * scale
    q_idx = jnp.arange(DIL_BLOCK)
    k_idx = jnp.arange(2 * DIL_BLOCK)
    rel = q_idx[:, None] + DIL_BLOCK - k_idx[None, :]
    band = (rel >= 0) & (rel <= n_back)
    blk = jnp.arange(nb)
    valid = band[None] & ((blk[:, None, None] > 0) | (k_idx >= DIL_BLOCK)[None, None, :])
    valid = valid[None, None, :, None]
    m = jnp.max(jnp.where(valid, scores, -jnp.inf), axis=-1)
    p = jnp.where(valid, jnp.exp(scores - m[..., None]), 0.0)
    s = jnp.sum(p, axis=-1)
    o = jnp.einsum('brnhqk,brnkhd->brnqhd', p, vv)

    def from_sub(x):
        rest = x.shape[4:]
        x = jnp.moveaxis(x.reshape((b, dilation, Ls) + rest), 1, 2)
        return x.reshape((b, L_pad) + rest)[:, :L]

    m = from_sub(jnp.swapaxes(m, 3, 4))
    s = from_sub(jnp.swapaxes(s, 3, 4))
    o = from_sub(o)
    return m, s, o


def dilated_attention(q, k, v):
    branches = [dilated_branch(q, k, v, w, d) for (w, d) in DIL_PATTERNS]
    m_all = jnp.stack([br[0] for br in branches])
    m_max = jnp.max(m_all, axis=0)
    wts = jnp.exp(m_all - m_max)
    num = sum(wts[i][..., None] * branches[i][2] for i in range(len(branches)))
    den = sum(wts[i] * branches[i][1] for i in range(len(branches)))
    return num / den[..., None]


def s5_layer(u, lam_re, lam_im, log_dt, b_re, b_im, c_re, c_im, d_skip, w_glu, b_glu):
    b, L, _ = u.shape
    uf = u.astype(jnp.float32)
    ug = uf.reshape(b, L, N_SSM_GROUPS, SSM_GROUP)
    a_re = jnp.minimum(lam_re.astype(jnp.float32), -1e-4)
    a_im = lam_im.astype(jnp.float32)
    dt = jnp.exp(log_dt.astype(jnp.float32))[:, None]
    mag = jnp.exp(dt * a_re)
    ang = dt * a_im
    abar_re = mag * jnp.cos(ang)
    abar_im = mag * jnp.sin(ang)
    den = a_re * a_re + a_im * a_im
    nr = abar_re - 1.0
    f_re = (nr * a_re + abar_im * a_im) / den
    f_im = (abar_im * a_re - nr * a_im) / den
    br = b_re.astype(jnp.float32)
    bi = b_im.astype(jnp.float32)
    bbar_re = f_re[..., None] * br - f_im[..., None] * bi
    bbar_im = f_re[..., None] * bi + f_im[..., None] * br
    bu_re = jnp.einsum('blgc,gnc->blgn', ug, bbar_re)
    bu_im = jnp.einsum('blgc,gnc->blgn', ug, bbar_im)
    ab_re = jnp.broadcast_to(abar_re, bu_re.shape)
    ab_im = jnp.broadcast_to(abar_im, bu_im.shape)

    def combine(e1, e2):
        a1r, a1i, b1r, b1i = e1
        a2r, a2i, b2r, b2i = e2
        return (a1r * a2r - a1i * a2i,
                a1r * a2i + a1i * a2r,
                a2r * b1r - a2i * b1i + b2r,
                a2r * b1i + a2i * b1r + b2i)

    _, _, x_re, x_im = lax.associative_scan(combine, (ab_re, ab_im, bu_re, bu_im), axis=1)
    y = (jnp.einsum('blgn,gcn->blgc', x_re, c_re.astype(jnp.float32))
         - jnp.einsum('blgn,gcn->blgc', x_im, c_im.astype(jnp.float32)))
    y = y.reshape(b, L, SSM_CHANNELS) + d_skip.astype(jnp.float32) * uf
    g = jax.nn.gelu(y)
    out = g * jax.nn.sigmoid(g @ w_glu.astype(jnp.float32) + b_glu.astype(jnp.float32))
    return out.astype(u.dtype)


def hybrid_layer(x, g_mix_pre, g_mix_post, g_ffn_pre, g_ffn_post, w_in,
                 g_out_sb, g_out_dil, g_out_ssm,
                 lam_re, lam_im, log_dt, b_re, b_im, c_re, c_im, d_skip, w_glu, b_glu,
                 w_out, w_gate, w_up, w_down):
    b, L, _ = x.shape
    h = rms_norm(x, g_mix_pre)
    proj = h @ w_in
    cuts = [SB_WIDTH, 2 * SB_WIDTH, 3 * SB_WIDTH,
            3 * SB_WIDTH + DIL_WIDTH, 3 * SB_WIDTH + 2 * DIL_WIDTH, 3 * SB_WIDTH + 3 * DIL_WIDTH]
    q_sb, k_sb, v_sb, q_dl, k_dl, v_dl, u_ssm = jnp.split(proj, cuts, axis=-1)
    heads_sb = lambda t: t.reshape(b, L, N_SB_HEADS, HEAD_DIM)
    heads_dl = lambda t: t.reshape(b, L, N_DIL_HEADS, HEAD_DIM)
    o_sb = stick_breaking_attention(heads_sb(q_sb), heads_sb(k_sb), heads_sb(v_sb))
    o_sb = o_sb.reshape(b, L, SB_WIDTH).astype(x.dtype)
    o_dl = dilated_attention(heads_dl(q_dl), heads_dl(k_dl), heads_dl(v_dl))
    o_dl = o_dl.reshape(b, L, DIL_WIDTH).astype(x.dtype)
    o_ssm = s5_layer(u_ssm, lam_re, lam_im, log_dt, b_re, b_im, c_re, c_im, d_skip, w_glu, b_glu)
    mixed = jnp.concatenate([rms_norm(o_sb, g_out_sb),
                             rms_norm(o_dl, g_out_dil),
                             rms_norm(o_ssm, g_out_ssm)], axis=-1)
    x = x + rms_norm(mixed @ w_out, g_mix_post)
    h = rms_norm(x, g_ffn_pre)
    f = (jax.nn.silu(h @ w_gate) * (h @ w_up)) @ w_down
    return x + rms_norm(f, g_ffn_post)


def setup_inputs(seed: int = 0) -> dict:
    key = jax.random.key(seed)
    ks = jax.random.split(key, 24)
    f32 = jnp.float32
    nrm = lambda k, shape, s: jax.random.normal(k, shape, f32) * s
    gain = lambda k, n: 1.0 + 0.02 * jax.random.normal(k, (DEPTH, n), f32)
    n_idx = jnp.arange(SSM_STATE, dtype=f32)
    lam_re = -0.5 + 0.01 * jax.random.normal(ks[9], (DEPTH, N_SSM_GROUPS, SSM_STATE), f32)
    lam_im = math.pi * n_idx[None, None, :] + 0.01 * jax.random.normal(ks[10], (DEPTH, N_SSM_GROUPS, SSM_STATE), f32)
    log_dt = jax.random.uniform(ks[11], (DEPTH, N_SSM_GROUPS), f32, math.log(1e-3), math.log(1e-1))
    return {
        "x": jax.random.normal(ks[0], (BATCH, SEQ, D_MODEL), f32),
        "norm_mix_pre": gain(ks[1], D_MODEL),
        "norm_mix_post": gain(ks[2], D_MODEL),
        "norm_ffn_pre": gain(ks[3], D_MODEL),
        "norm_ffn_post": gain(ks[4], D_MODEL),
        "w_in": nrm(ks[5], (DEPTH, D_MODEL, IN_WIDTH), D_MODEL ** -0.5),
        "norm_out_sb": gain(ks[6], SB_WIDTH),
        "norm_out_dil": gain(ks[7], DIL_WIDTH),
        "norm_out_ssm": gain(ks[8], SSM_CHANNELS),
        "ssm_lambda_re": lam_re,
        "ssm_lambda_im": lam_im,
        "ssm_log_dt": log_dt,
        "ssm_b_re": nrm(ks[12], (DEPTH, N_SSM_GROUPS, SSM_STATE, SSM_GROUP), (2.0 * SSM_GROUP) ** -0.5),
        "ssm_b_im": nrm(ks[13], (DEPTH, N_SSM_GROUPS, SSM_STATE, SSM_GROUP), (2.0 * SSM_GROUP) ** -0.5),
        "ssm_c_re": nrm(ks[14], (DEPTH, N_SSM_GROUPS, SSM_GROUP, SSM_STATE), (2.0 * SSM_STATE) ** -0.5),
        "ssm_c_im": nrm(ks[15], (DEPTH, N_SSM_GROUPS, SSM_GROUP, SSM_STATE), (2.0 * SSM_STATE) ** -0.5),
        "ssm_d": nrm(ks[16], (DEPTH, SSM_CHANNELS), 1.0),
        "ssm_w_glu": nrm(ks[17], (DEPTH, SSM_CHANNELS, SSM_CHANNELS), SSM_CHANNELS ** -0.5),
        "ssm_b_glu": nrm(ks[18], (DEPTH, SSM_CHANNELS), 0.02),
        "w_out": nrm(ks[19], (DEPTH, MIX_WIDTH, D_MODEL), MIX_WIDTH ** -0.5),
        "ffn_w_gate": nrm(ks[20], (DEPTH, D_MODEL, FFN_HIDDEN), D_MODEL ** -0.5),
        "ffn_w_up": nrm(ks[21], (DEPTH, D_MODEL, FFN_HIDDEN), D_MODEL ** -0.5),
        "ffn_w_down": nrm(ks[22], (DEPTH, FFN_HIDDEN, D_MODEL), FFN_HIDDEN ** -0.5),
    }


def reference(x, norm_mix_pre, norm_mix_post, norm_ffn_pre, norm_ffn_post, w_in,
              norm_out_sb, norm_out_dil, norm_out_ssm,
              ssm_lambda_re, ssm_lambda_im, ssm_log_dt, ssm_b_re, ssm_b_im, ssm_c_re, ssm_c_im,
              ssm_d, ssm_w_glu, ssm_b_glu, w_out, ffn_w_gate, ffn_w_up, ffn_w_down):
    for l in range(DEPTH):
        x = hybrid_layer(x, norm_mix_pre[l], norm_mix_post[l], norm_ffn_pre[l], norm_ffn_post[l], w_in[l],
                         norm_out_sb[l], norm_out_dil[l], norm_out_ssm[l],
                         ssm_lambda_re[l], ssm_lambda_im[l], ssm_log_dt[l], ssm_b_re[l], ssm_b_im[l],
                         ssm_c_re[l], ssm_c_im[l], ssm_d[l], ssm_w_glu[l], ssm_b_glu[l],
                         w_out[l], ffn_w_gate[l], ffn_w_up[l], ffn_w_down[l])
    return x
```

```cpp
#include <hip/hip_runtime.h>
#include <cstdio>
#include <cstdint>
namespace pg8 {
#define PG8_LAS __attribute__((address_space(3)))
typedef unsigned short bf16_t;
typedef short bf16x8 __attribute__((ext_vector_type(8)));
typedef float f32x4 __attribute__((ext_vector_type(4)));
typedef unsigned u32x4 __attribute__((ext_vector_type(4)));
constexpr int BM = 256, BK = 64, HALF = 128, HTB = HALF * BK * 2  , STAGE_BYTES = 8 * HTB, NXCD = 8, WGM = 8;

__host__ __device__ __forceinline__ int lds_byte(int r, int c) { const int st = (r >> 4) * 2 + (c >> 5), rr = r & 15, cc = c & 31, ob = rr * 64 + cc * 2; return st * 1024 + (ob ^ (((ob >> 9) & 1) << 5)); }
__host__ __device__ __forceinline__ void stage_rc(int b, int& R, int& C) { const int st = b / 1024, sb = b % 1024, swz = sb ^ (((sb >> 9) & 1) << 5); R = (st >> 1) * 16 + swz / 64; C = (st & 1) * 32 + (swz % 64) / 2; }
__host__ __device__ __forceinline__ int perm32(int rho) { const int n = rho >> 4, i = rho & 15; return 8 * (i >> 2) + 4 * n + (i & 3); }

struct Unit { int pm, pn; };
struct Gemm { const bf16_t* A; const bf16_t* Bt; int M, N, K; };

struct StaticOrder {
    int nM, nN, nwg, G, c;
    __host__ __device__ void init(int M, int N, int G_, int c_) { nM = M / BM; nN = N / BM; nwg = nM * nN; G = G_; c = c_; }
    __host__ __device__ bool next(int i, Unit& u) const {
        const long L = (long)i * G + c; if (L >= nwg) return false;
        int wgid = (int)L; { const int q = nwg / NXCD, r = nwg % NXCD, xcd = wgid % NXCD, off = wgid / NXCD; wgid = (xcd < r ? xcd * (q + 1) : r * (q + 1) + (xcd - r) * q) + off; }
        const int nig = WGM * nN, gid = wgid / nig, fm = gid * WGM, gsz = (nM - fm) < WGM ? (nM - fm) : WGM;
        u.pm = fm + ((wgid % nig) % gsz); u.pn = (wgid % nig) / gsz; return true;
    }
    __device__ __forceinline__ void a_ready(const Unit&) const {}
    __device__ __forceinline__ void done(const Unit&) const {}
};


__device__ __forceinline__ unsigned cvt_pk_bf16(float lo, float hi) { unsigned r; asm volatile("v_cvt_pk_bf16_f32 %0, %1, %2" : "=v"(r) : "v"(lo), "v"(hi)); return r; }
__device__ __forceinline__ float bf_lo(unsigned w) { return __uint_as_float(w << 16); }
__device__ __forceinline__ float bf_hi(unsigned w) { return __uint_as_float(w & 0xffff0000u); }
__device__ __forceinline__ float fast_sigmoid(float x) { return __builtin_amdgcn_rcpf(1.0f + __builtin_amdgcn_exp2f(-1.4426950408889634f * x)); }

struct EpiStoreBf16 {
    static constexpr bool PERM = true, AFTER_DRAIN = false;
    bf16_t* O; int ldc;
    __device__ __forceinline__ void operator()(const f32x4 (&acc)[2][2][4][2], const Unit& u, int wr, int wc, int fr, int fq) const {
        const int row0 = u.pm * BM + wr * 64 + fr, col0 = u.pn * BM + wc * 32 + 8 * fq;
#pragma unroll
        for (int ai = 0; ai < 2; ++ai)
#pragma unroll
            for (int m = 0; m < 4; ++m) { bf16_t* rowp = O + (size_t)(row0 + ai * HALF + m * 16) * ldc + col0;
#pragma unroll
                for (int bj = 0; bj < 2; ++bj) { const f32x4 v0 = acc[ai][bj][m][0], v1 = acc[ai][bj][m][1];
                    u32x4 w; w.x = cvt_pk_bf16(v0[0], v0[1]); w.y = cvt_pk_bf16(v0[2], v0[3]); w.z = cvt_pk_bf16(v1[0], v1[1]); w.w = cvt_pk_bf16(v1[2], v1[3]);
                    *(u32x4*)(rowp + bj * HALF) = w; } }
    }
};
struct EpiSwiGLU {
    static constexpr bool PERM = true, AFTER_DRAIN = false;
    bf16_t* H; int ldh;
    __device__ __forceinline__ void operator()(const f32x4 (&acc)[2][2][4][2], const Unit& u, int wr, int wc, int fr, int fq) const {
        const int row0 = u.pm * BM + wr * 64 + fr, col0 = u.pn * HALF + wc * 32 + 8 * fq;
#pragma unroll
        for (int ai = 0; ai < 2; ++ai)
#pragma unroll
            for (int m = 0; m < 4; ++m) { bf16_t* rowp = H + (size_t)(row0 + ai * HALF + m * 16) * ldh + col0;
                float h[8];
#pragma unroll
                for (int n = 0; n < 2; ++n)
#pragma unroll
                    for (int e = 0; e < 4; ++e) { const float g = acc[ai][0][m][n][e], up = acc[ai][1][m][n][e]; h[4 * n + e] = g * fast_sigmoid(g) * up; }
                u32x4 w; w.x = cvt_pk_bf16(h[0], h[1]); w.y = cvt_pk_bf16(h[2], h[3]); w.z = cvt_pk_bf16(h[4], h[5]); w.w = cvt_pk_bf16(h[6], h[7]);
                *(u32x4*)rowp = w; }
    }
};
struct EpiGlu {
    static constexpr bool PERM = true, AFTER_DRAIN = false;
    const bf16_t* Gv; bf16_t* O; int ldc; const float* bias;
    __device__ __forceinline__ void operator()(const f32x4 (&acc)[2][2][4][2], const Unit& u, int wr, int wc, int fr, int fq) const {
        const int row0 = u.pm * BM + wr * 64 + fr, col0 = u.pn * BM + wc * 32 + 8 * fq;
        f32x4 bv[2][2];
#pragma unroll
        for (int bj = 0; bj < 2; ++bj)
#pragma unroll
            for (int n = 0; n < 2; ++n) bv[bj][n] = *(const f32x4*)(bias + col0 + bj * HALF + 4 * n);
#pragma unroll
        for (int ai = 0; ai < 2; ++ai)
#pragma unroll
            for (int m = 0; m < 4; ++m) { const size_t off = (size_t)(row0 + ai * HALF + m * 16) * ldc + col0;
#pragma unroll
                for (int bj = 0; bj < 2; ++bj) { const u32x4 gw = *(const u32x4*)(Gv + off + bj * HALF);
                    const f32x4 v0 = acc[ai][bj][m][0] + bv[bj][0], v1 = acc[ai][bj][m][1] + bv[bj][1];
                    u32x4 w;
                    w.x = cvt_pk_bf16(bf_lo(gw.x) * fast_sigmoid(v0[0]), bf_hi(gw.x) * fast_sigmoid(v0[1]));
                    w.y = cvt_pk_bf16(bf_lo(gw.y) * fast_sigmoid(v0[2]), bf_hi(gw.y) * fast_sigmoid(v0[3]));
                    w.z = cvt_pk_bf16(bf_lo(gw.z) * fast_sigmoid(v1[0]), bf_hi(gw.z) * fast_sigmoid(v1[1]));
                    w.w = cvt_pk_bf16(bf_lo(gw.w) * fast_sigmoid(v1[2]), bf_hi(gw.w) * fast_sigmoid(v1[3]));
                    *(u32x4*)(O + off + bj * HALF) = w; } }
    }
};

template <class Epi, class Sched, bool ALIGN_EPI = false, bool SP2 = false>
__device__ __forceinline__ void gemm_phase(PG8_LAS unsigned char* lds, const Gemm g, const Sched& S, const Epi& E, const int wid) {
    int lane_; asm volatile("v_mbcnt_lo_u32_b32 %0, -1, 0\n\tv_mbcnt_hi_u32_b32 %0, -1, %0" : "=v"(lane_));
    int wid_ = wid; asm volatile("" : "+s"(wid_));
    const int lane = lane_, tid = wid_ * 64 + lane, wr = wid_ >> 2, wc = wid_ & 3, fr = lane & 15, fq = lane >> 4;
    const int K = g.K, nt = K / BK;
    unsigned voffA[2], voffB[2];
#pragma unroll
    for (int i = 0; i < 2; ++i) { int R, C; stage_rc(tid * 16 + i * 8192, R, C); const int Rb = Epi::PERM ? ((R & ~31) + perm32(R & 31)) : R;
        voffA[i] = (unsigned)(R * K + C) * 2u; voffB[i] = (unsigned)(Rb * K + C) * 2u; }
    const size_t kstep = (size_t)(BK * 2);
    const size_t hstep = (size_t)HALF * K * 2;
    const size_t tstep = 2 * hstep;
    const unsigned ldsw = (unsigned)wid_ * 1024u;
    const int aoff = lds_byte(wr * 64 + fr, fq * 8), boff = lds_byte(wc * 32 + fr, fq * 8);
#define PG8_SA(b, h) (((b) * 2 + (h)) * HTB)
#define PG8_SB(b, h) ((4 + (b) * 2 + (h)) * HTB)
#define PG8_STAGE(bufoff, gbase, voff) do { _Pragma("unroll") for (int _i = 0; _i < 2; ++_i) \
        __builtin_amdgcn_global_load_lds((const unsigned*)((const char*)(gbase) + (voff)[_i]), (PG8_LAS unsigned*)(lds + (bufoff) + ldsw + _i * 8192), 16, 0, 0); } while (0)
#define PG8_LDA(dst, b, h) do { _Pragma("unroll") for (int m = 0; m < 4; ++m) _Pragma("unroll") for (int k = 0; k < 2; ++k) dst[m][k] = *(const PG8_LAS bf16x8*)(lds + PG8_SA(b, h) + aoff + m * 2048 + k * 1024); } while (0)
#define PG8_LDB(dst, b, h) do { _Pragma("unroll") for (int n = 0; n < 2; ++n) _Pragma("unroll") for (int k = 0; k < 2; ++k) dst[n][k] = *(const PG8_LAS bf16x8*)(lds + PG8_SB(b, h) + boff + n * 2048 + k * 1024); } while (0)
#define PG8_MMA(ai, bj, At, Bt) do { __builtin_amdgcn_s_setprio(1); _Pragma("unroll") for (int m = 0; m < 4; ++m) _Pragma("unroll") for (int n = 0; n < 2; ++n) _Pragma("unroll") for (int k = 0; k < 2; ++k) \
        acc[ai][bj][m][n] = __builtin_amdgcn_mfma_f32_16x16x32_bf16(Bt[n][k], At[m][k], acc[ai][bj][m][n], 0, 0, 0); __builtin_amdgcn_s_setprio(0); } while (0)
#define PG8_WAIT_V(n) asm volatile("s_waitcnt vmcnt(" #n ")" ::: "memory")
#define PG8_WAIT_L(n) asm volatile("s_waitcnt lgkmcnt(" #n ")" ::: "memory")
#define PG8_BAR __builtin_amdgcn_s_barrier()
#define PG8_SCHED __builtin_amdgcn_sched_barrier(0)
    Unit cur, nxt; int ui = 0;
    if (!S.next(0, cur)) return;
    f32x4 acc[2][2][4][2];
#pragma unroll
    for (int a = 0; a < 2; ++a)
#pragma unroll
        for (int b = 0; b < 2; ++b)
#pragma unroll
            for (int m = 0; m < 4; ++m)
#pragma unroll
                for (int n = 0; n < 2; ++n) acc[a][b][m][n] = (f32x4){0.f, 0.f, 0.f, 0.f};
    bf16x8 At[4][2], B0[2][2], B1[2][2];
    const char* cA = (const char*)g.A + (size_t)cur.pm * tstep; const char* cB = (const char*)g.Bt + (size_t)cur.pn * tstep;
    S.a_ready(cur);
    if constexpr (SP2) {
        PG8_STAGE(PG8_SB(0, 0), cB, voffB); PG8_STAGE(PG8_SB(0, 1), cB + hstep, voffB); PG8_STAGE(PG8_SA(0, 0), cA, voffA); PG8_STAGE(PG8_SA(0, 1), cA + hstep, voffA);
        if (wr == 1) PG8_BAR;
        PG8_WAIT_V(2); PG8_BAR;
        PG8_STAGE(PG8_SB(1, 0), cB + kstep, voffB); PG8_STAGE(PG8_SA(1, 0), cA + kstep, voffA); PG8_STAGE(PG8_SB(1, 1), cB + hstep + kstep, voffB);
        PG8_WAIT_V(6); PG8_BAR;
    } else {
        PG8_STAGE(PG8_SB(0, 0), cB, voffB); PG8_STAGE(PG8_SA(0, 0), cA, voffA); PG8_STAGE(PG8_SB(0, 1), cB + hstep, voffB); PG8_STAGE(PG8_SA(0, 1), cA + hstep, voffA);
        if (wr == 1) PG8_BAR;
        PG8_WAIT_V(4); PG8_BAR;
        PG8_STAGE(PG8_SB(1, 0), cB + kstep, voffB); PG8_STAGE(PG8_SA(1, 0), cA + kstep, voffA); PG8_STAGE(PG8_SB(1, 1), cB + hstep + kstep, voffB);
        PG8_WAIT_V(6); PG8_BAR;
    }
    for (;;) {
        const bool has_next = S.next(ui + 1, nxt);
        const char* nA = has_next ? (const char*)g.A + (size_t)nxt.pm * tstep : cA; const char* nB = has_next ? (const char*)g.Bt + (size_t)nxt.pn * tstep : cB;
        for (int t = 0; t < nt; t += 2) {
            const bool last = (t == nt - 2);
            const char* a1 = cA + (size_t)(t + 1) * kstep;
            const char* a2 = last ? nA : cA + (size_t)(t + 2) * kstep; const char* b2 = last ? nB : cB + (size_t)(t + 2) * kstep;
            const char* a3 = a2 + kstep; const char* b3 = b2 + kstep;
            if (last && has_next) S.a_ready(nxt);
            if constexpr (SP2) {
            PG8_LDB(B0, 0, 0); PG8_LDB(B1, 0, 1); PG8_SCHED; PG8_LDA(At, 0, 0); PG8_STAGE(PG8_SA(1, 1), a1 + hstep, voffA);
            PG8_WAIT_V(8); PG8_WAIT_L(0); PG8_BAR; PG8_MMA(0, 0, At, B0); PG8_MMA(0, 1, At, B1); PG8_BAR; PG8_SCHED;
            PG8_LDA(At, 0, 1); PG8_STAGE(PG8_SB(0, 0), b2, voffB); PG8_STAGE(PG8_SB(0, 1), b2 + hstep, voffB); PG8_STAGE(PG8_SA(0, 0), a2, voffA);
            PG8_WAIT_V(8); PG8_WAIT_L(0); PG8_BAR; PG8_MMA(1, 0, At, B0); PG8_MMA(1, 1, At, B1); PG8_BAR; PG8_SCHED;
            PG8_LDB(B0, 1, 0); PG8_LDB(B1, 1, 1); PG8_SCHED; PG8_LDA(At, 1, 0); PG8_STAGE(PG8_SA(0, 1), a2 + hstep, voffA);
            PG8_WAIT_V(8); PG8_WAIT_L(0); PG8_BAR; PG8_MMA(0, 0, At, B0); PG8_MMA(0, 1, At, B1); PG8_BAR; PG8_SCHED;
            PG8_LDA(At, 1, 1); PG8_STAGE(PG8_SB(1, 0), b3, voffB); PG8_STAGE(PG8_SB(1, 1), b3 + hstep, voffB); PG8_STAGE(PG8_SA(1, 0), a3, voffA);
            PG8_WAIT_V(8); PG8_WAIT_L(0); PG8_BAR; PG8_MMA(1, 0, At, B0); PG8_MMA(1, 1, At, B1); PG8_BAR; PG8_SCHED;
            } else {
            PG8_LDB(B0, 0, 0); PG8_SCHED; PG8_LDA(At, 0, 0); PG8_STAGE(PG8_SA(1, 1), a1 + hstep, voffA);
            PG8_WAIT_L(8); PG8_BAR; PG8_WAIT_L(0); PG8_MMA(0, 0, At, B0); PG8_BAR; PG8_SCHED;
            PG8_LDB(B1, 0, 1); PG8_STAGE(PG8_SB(0, 0), b2, voffB);
            PG8_BAR; PG8_WAIT_L(0); PG8_MMA(0, 1, At, B1); PG8_BAR;
            PG8_LDA(At, 0, 1); PG8_STAGE(PG8_SA(0, 0), a2, voffA);
            PG8_BAR; PG8_WAIT_L(0); PG8_MMA(1, 0, At, B0); PG8_BAR; PG8_SCHED;
            PG8_STAGE(PG8_SB(0, 1), b2 + hstep, voffB);
            PG8_WAIT_V(6); PG8_BAR; PG8_MMA(1, 1, At, B1); PG8_BAR;
            PG8_LDB(B0, 1, 0); PG8_SCHED; PG8_LDA(At, 1, 0); PG8_STAGE(PG8_SA(0, 1), a2 + hstep, voffA);
            PG8_WAIT_L(8); PG8_BAR; PG8_WAIT_L(0); PG8_MMA(0, 0, At, B0); PG8_BAR; PG8_SCHED;
            PG8_LDB(B1, 1, 1); PG8_STAGE(PG8_SB(1, 0), b3, voffB);
            PG8_BAR; PG8_WAIT_L(0); PG8_MMA(0, 1, At, B1); PG8_BAR;
            PG8_LDA(At, 1, 1); PG8_STAGE(PG8_SA(1, 0), a3, voffA);
            PG8_BAR; PG8_WAIT_L(0); PG8_MMA(1, 0, At, B0); PG8_BAR; PG8_SCHED;
            PG8_STAGE(PG8_SB(1, 1), b3 + hstep, voffB);
            PG8_WAIT_V(6); PG8_BAR; PG8_MMA(1, 1, At, B1); PG8_BAR;
            }
        }
        if constexpr (ALIGN_EPI) { if (wr == 0) PG8_BAR; }
        if constexpr (!Epi::AFTER_DRAIN) { E(acc, cur, wr, wc, fr, fq); S.done(cur); }
        if (!has_next) break;
#pragma unroll
        for (int a = 0; a < 2; ++a)
#pragma unroll
            for (int b = 0; b < 2; ++b)
#pragma unroll
                for (int m = 0; m < 4; ++m)
#pragma unroll
                    for (int n = 0; n < 2; ++n) acc[a][b][m][n] = (f32x4){0.f, 0.f, 0.f, 0.f};
        cur = nxt; cA = nA; cB = nB; ++ui;
        if constexpr (ALIGN_EPI) { if (wr == 1) PG8_BAR; }
    }
    PG8_WAIT_V(0);
    if constexpr (!ALIGN_EPI) { if (wr == 0) PG8_BAR; }
    PG8_BAR;
    if constexpr (Epi::AFTER_DRAIN) { E.fused(acc, cur, wr, wc, fr, fq, lds, wid, lane); S.done(cur); }
#undef PG8_SA
#undef PG8_SB
#undef PG8_STAGE
#undef PG8_LDA
#undef PG8_LDB
#undef PG8_MMA
#undef PG8_WAIT_V
#undef PG8_WAIT_L
#undef PG8_BAR
#undef PG8_SCHED
}
}

constexpr int NWAVES = 8;
#ifndef MK_SINGLE
#define MK_SINGLE 1
#endif

constexpr int SEQ = 8192, DM = 4096, DEPTH = 2, HD = 128, SSMC = 1024, NSBH = 12, NDLH = 12, SBW = 1536, DLW = 1536, INW = 10240, FFN = 11008, GUW = 2 * FFN;
constexpr int NGRP = 64, NST = 64, SGRP = 16;
constexpr int C_QSB = 0, C_KSB = 1536, C_VSB = 3072, C_QDL = 4608, C_KDL = 6144, C_VDL = 7680, C_USSM = 9216;
constexpr float RMS_EPS = 1e-6f;
constexpr float ATT_SCALE = 0.08838834764831845f;
constexpr int SSM_T = 128, SSM_NCH = SEQ / SSM_T;
constexpr int STEPS_PER_LAYER = 10, NSTEPS = 1 + DEPTH * STEPS_PER_LAYER;

constexpr size_t MiB = 1u << 20;
constexpr size_t WS_CTL = 0, CTL_ZERO_BYTES = 1 * MiB;
constexpr size_t WS_W = 3 * MiB, WL_BYTES = 372 * MiB;
constexpr size_t WO_IN = 0, WO_GLU = 80 * MiB, WO_OUT = 82 * MiB, WO_GU = 114 * MiB, WO_DN = 286 * MiB;
constexpr size_t WS_XN = 747 * MiB;
constexpr size_t WS_PROJ = 811 * MiB;
constexpr size_t WS_OSB = 971 * MiB;
constexpr size_t WS_H = 811 * MiB;
constexpr size_t WS_MIX = 995 * MiB;
constexpr size_t WS_F = 1059 * MiB;
constexpr size_t WS_X1 = 1123 * MiB;
constexpr size_t WS_ODL = 1251 * MiB;
constexpr size_t WS_G = 1323 * MiB;
constexpr size_t WS_OSSM = 1339 * MiB;
constexpr size_t WS_XE = 1355 * MiB;
constexpr size_t WS_STAT = 1357 * MiB;
constexpr size_t WS_TAB = 1 * MiB;
constexpr size_t WS_END = 1360 * MiB;
static_assert(WS_W + DEPTH * WL_BYTES <= WS_XN && WS_H + (size_t)SEQ * FFN * 2 <= WS_MIX && WS_PROJ + (size_t)SEQ * INW * 2 <= WS_OSB, "d_ws map");
constexpr int CW_TMO = 0, CW_CODE = 1, CW_BAR = 4096;

constexpr int WAVE_LDS = 18432;
constexpr int LDSCTL_OFF = 8 * WAVE_LDS, MISC_OFF = LDSCTL_OFF + 320;
constexpr int LDS_BYTES = 148480;
static_assert(MISC_OFF + 128 <= LDS_BYTES && 8 * WAVE_LDS >= 131072, "LDS map");

#define GAS __attribute__((address_space(1)))
#define LAS __attribute__((address_space(3)))
typedef unsigned short bf16;
typedef unsigned v4u __attribute__((ext_vector_type(4)));
typedef unsigned v2u __attribute__((ext_vector_type(2)));
typedef float f32x4 __attribute__((ext_vector_type(4)));
typedef float f32x2 __attribute__((ext_vector_type(2)));
typedef short bf16x8 __attribute__((ext_vector_type(8)));
typedef GAS unsigned gu32;
#define RLX_AGENT __ATOMIC_RELAXED, __HIP_MEMORY_SCOPE_AGENT
#define LDS_WAIT() asm volatile("s_waitcnt lgkmcnt(0)" ::: "memory")
#define VM_WAIT() asm volatile("s_waitcnt vmcnt(0)" ::: "memory")
__device__ __forceinline__ int fresh_lane() { int l; asm volatile("v_mbcnt_lo_u32_b32 %0, -1, 0\n\tv_mbcnt_hi_u32_b32 %0, -1, %0" : "=v"(l)); return l; }
__device__ __forceinline__ unsigned pk2(float lo, float hi) { return pg8::cvt_pk_bf16(lo, hi); }
__device__ __forceinline__ float bflo(unsigned w) { return __uint_as_float(w << 16); }
__device__ __forceinline__ float bfhi(unsigned w) { return __uint_as_float(w & 0xffff0000u); }
__device__ __forceinline__ float bf2f(bf16 h) { return __uint_as_float((unsigned)h << 16); }
__device__ __forceinline__ float wave_sum(float v) {
#pragma unroll
    for (int o = 1; o < 64; o <<= 1) v += __shfl_xor(v, o);
    return v;
}
__device__ __forceinline__ float wave_max(float v) {
#pragma unroll
    for (int o = 1; o < 64; o <<= 1) v = fmaxf(v, __shfl_xor(v, o));
    return v;
}
#define XB_TMO      128
#define XB_XCNT(j)  (256  + 64 * (j))
#define XB_XSUB(j)  (1280 + 64 * (j))
#define XB_XGEN(j)  (2304 + 64 * (j))
#define XB_TOP      3328
#define XB_TOPGEN   3392
#define XCD_BAR_WORDS 3456
#define XB_SPIN_CAP (1u << 18)

__device__ __forceinline__ unsigned xb_ld(unsigned* p)              { return __hip_atomic_load(p, __ATOMIC_RELAXED, __HIP_MEMORY_SCOPE_AGENT); }
__device__ __forceinline__ unsigned xb_add(unsigned* p, unsigned v) { return __hip_atomic_fetch_add(p, v, __ATOMIC_RELAXED, __HIP_MEMORY_SCOPE_AGENT); }
__device__ __forceinline__ unsigned xb_xcc_id() { return (unsigned)__builtin_amdgcn_s_getreg((3 << 11) | 20) & 0xFu; }
#define XB_SPIN(cond, bar) do { unsigned _sp = 0; while (cond) { __builtin_amdgcn_s_sleep(1); \
    if ((++_sp & 255u) == 0u) { if (xb_ld(&(bar)[XB_TMO])) break; if (_sp > XB_SPIN_CAP) { atomicAdd(&(bar)[XB_TMO], 1u); break; } } } } while (0)

struct XcdBarrier {
    unsigned* bar; unsigned x;
    int w;
    volatile LAS unsigned* st;
};

__device__ __forceinline__ XcdBarrier xcd_barrier_post(unsigned* bar, volatile LAS unsigned* st, int wave) {
    XcdBarrier b; b.bar = bar; b.x = xb_xcc_id(); b.st = st; b.w = wave;
    if (wave == 0 && fresh_lane() == 0) (void)xb_add(&bar[XB_XCNT(b.x)], 1u);
    return b;
}
__device__ __forceinline__ void xcd_barrier_complete(unsigned* bar, unsigned x, unsigned& nloc, unsigned& nx) {
    const unsigned G = gridDim.x * gridDim.y * gridDim.z;
    unsigned sum, cnt, mine, sp = 0u;
    for (;;) {
        sum = 0u; cnt = 0u; mine = 0u;
#pragma unroll
        for (unsigned j = 0; j < 16; ++j) { const unsigned c = xb_ld(&bar[XB_XCNT(j)]); sum += c; cnt += (c > 0u) ? 1u : 0u; mine = (j == x) ? c : mine; }
        if (sum == G) break;
        __builtin_amdgcn_s_sleep(1);
        if ((++sp & 255u) == 0u) { if (xb_ld(&bar[XB_TMO])) break; if (sp > XB_SPIN_CAP) { atomicAdd(&bar[XB_TMO], 1u); break; } }
    }
    nloc = mine > 0u ? mine : 1u; nx = cnt > 0u ? cnt : 1u;
}

__device__ __forceinline__ void xcd_barrier(const XcdBarrier& b) {
    asm volatile("s_waitcnt vmcnt(0)" ::: "memory");
    __syncthreads();
    if (b.w == 0 && fresh_lane() == 0) {
        unsigned* bar = b.bar;
        __builtin_amdgcn_s_waitcnt(0);
        unsigned nloc = b.st[0], nx = b.st[1];
        if (nloc == 0u) { xcd_barrier_complete(bar, b.x, nloc, nx); b.st[0] = nloc; b.st[1] = nx; }
        const unsigned old = xb_add(&bar[XB_XSUB(b.x)], 1u);
        const unsigned gen = old / nloc;
        if (old + 1u == (gen + 1u) * nloc) {
            __builtin_amdgcn_fence(__ATOMIC_RELEASE, "agent");
            asm volatile("s_waitcnt vmcnt(0)" ::: "memory");
            const unsigned og = xb_add(&bar[XB_TOP], 1u);
            const unsigned tg = og / nx;
            if (og + 1u == (tg + 1u) * nx) xb_add(&bar[XB_TOPGEN], 1u);
            else XB_SPIN(xb_ld(&bar[XB_TOPGEN]) == tg, bar);
            __builtin_amdgcn_fence(__ATOMIC_ACQUIRE, "agent");
            xb_add(&bar[XB_XGEN(b.x)], 1u);
            asm volatile("s_waitcnt vmcnt(0)" ::: "memory");
        } else {
            XB_SPIN(xb_ld(&bar[XB_XGEN(b.x)]) == gen, bar);
            __builtin_amdgcn_fence(__ATOMIC_ACQUIRE, "agent");
            asm volatile("s_waitcnt vmcnt(0)" ::: "memory");
        }
    }
    __syncthreads();
}

#ifndef USE_NT
#define USE_NT 1
#endif
#if USE_NT
#define NT_LD(p) __builtin_nontemporal_load(p)
#define NT_ST(p, v) __builtin_nontemporal_store(v, p)
#else
#define NT_LD(p) (*(p))
#define NT_ST(p, v) (*(p) = (v))
#endif
__device__ __forceinline__ void tr_tile(const float* W, int K, int N, bf16* WT, int k0, int n0, int orow0, LAS float* scr, int lane_) {
    int lane = lane_; asm volatile("" : "+v"(lane));
#pragma unroll 4
    for (int i = 0; i < 16; ++i) { const int kk = 4 * i + (lane >> 4), c = (lane & 15) * 4;
        const f32x4 v = *(const f32x4*)(W + (size_t)(k0 + kk) * N + n0 + c);
        LAS float* d = scr + kk * 65 + c; d[0] = v.x; d[1] = v.y; d[2] = v.z; d[3] = v.w; }
    LDS_WAIT(); asm volatile("" ::: "memory");
    const int c8 = lane & 7;
#pragma unroll
    for (int j = 0; j < 8; ++j) { const int n = (lane >> 3) + 8 * j; const LAS float* s = scr + (8 * c8) * 65 + n;
        v4u o; o.x = pk2(s[0], s[65]); o.y = pk2(s[130], s[195]); o.z = pk2(s[260], s[325]); o.w = pk2(s[390], s[455]);
        *(v4u*)(WT + (size_t)(orow0 + n) * K + k0 + 8 * c8) = o; }
    LDS_WAIT(); asm volatile("" ::: "memory");
}

struct ConvItem { const float* W; bf16* WT; int K, N, k0, n0, orow0; };
__device__ __forceinline__ void tr_load(const ConvItem& c, int lane_, f32x4 (&v)[16]) {
    int lane = lane_; asm volatile("" : "+v"(lane));
    const float* src = c.W + (size_t)(c.k0 + (lane >> 4)) * c.N + c.n0 + (lane & 15) * 4;
#pragma unroll
    for (int i = 0; i < 16; ++i) v[i] = NT_LD((const f32x4*)(src + (size_t)(4 * i) * c.N));
}
__device__ __forceinline__ void tr_store(const ConvItem& c, LAS float* scr, int lane_, const f32x4 (&v)[16]) {
    int lane = lane_; asm volatile("" : "+v"(lane));
#pragma unroll
    for (int i = 0; i < 16; ++i) { LAS float* d = scr + (4 * i + (lane >> 4)) * 65 + (lane & 15) * 4; d[0] = v[i].x; d[1] = v[i].y; d[2] = v[i].z; d[3] = v[i].w; }
    LDS_WAIT(); asm volatile("" ::: "memory");
    const int c8 = lane & 7;
#pragma unroll
    for (int j = 0; j < 8; ++j) { const int n = (lane >> 3) + 8 * j; const LAS float* s = scr + (8 * c8) * 65 + n;
        v4u o; o.x = pk2(s[0], s[65]); o.y = pk2(s[130], s[195]); o.z = pk2(s[260], s[325]); o.w = pk2(s[390], s[455]);
        *(v4u*)(c.WT + (size_t)(c.orow0 + n) * c.K + c.k0 + 8 * c8) = o; }
    LDS_WAIT(); asm volatile("" ::: "memory");
}
__device__ __forceinline__ f32x4 ld_row4(const float* p) { return NT_LD((const f32x4*)p); }
__device__ __forceinline__ f32x4 ld_row4(const bf16* p) { const v2u w = NT_LD((const v2u*)p); return (f32x4){bflo(w.x), bfhi(w.x), bflo(w.y), bfhi(w.y)}; }
__device__ __forceinline__ void st_row4(float* p, const f32x4& v) { NT_ST((f32x4*)p, v); }
__device__ __forceinline__ void st_row4(bf16* p, const f32x4& v) { v2u o; o.x = pk2(v.x, v.y); o.y = pk2(v.z, v.w); NT_ST((v2u*)p, o); }
template <typename TI, typename TO>
__device__ __forceinline__ void row_op(const TI* xin, const bf16* f, const float* gpost, TO* xout, const float* gpre, bf16* xn, int lane_) {
    int lane = lane_; asm volatile("" : "+v"(lane));
    f32x4 x[16];
    if (f) {
        v2u fw[16]; float ss = 0.f;
#pragma unroll
        for (int j = 0; j < 16; ++j) { fw[j] = *(const v2u*)(f + 4 * lane + 256 * j);
            const float a = bflo(fw[j].x), b = bfhi(fw[j].x), c = bflo(fw[j].y), d = bfhi(fw[j].y); ss += (a * a + b * b) + (c * c + d * d); }
        const float r1 = 1.0f / sqrtf(wave_sum(ss) * (1.0f / DM) + RMS_EPS);
#pragma unroll
        for (int j = 0; j < 16; ++j) { const f32x4 xv = ld_row4(xin + 4 * lane + 256 * j), gp = *(const f32x4*)(gpost + 4 * lane + 256 * j);
            x[j].x = xv.x + bflo(fw[j].x) * r1 * gp.x; x[j].y = xv.y + bfhi(fw[j].x) * r1 * gp.y; x[j].z = xv.z + bflo(fw[j].y) * r1 * gp.z; x[j].w = xv.w + bfhi(fw[j].y) * r1 * gp.w;
            if ((j & (sizeof(TI) == 2 ? 7 : 3)) == (sizeof(TI) == 2 ? 7 : 3)) asm volatile("" ::: "memory"); }
    } else {
#pragma unroll
        for (int j = 0; j < 16; ++j) x[j] = ld_row4(xin + 4 * lane + 256 * j);
    }
    if (xout) {
#pragma unroll
        for (int j = 0; j < 16; ++j) st_row4(xout + 4 * lane + 256 * j, x[j]);
    }
    if (xn) {
        float s2 = 0.f;
#pragma unroll
        for (int j = 0; j < 16; ++j) s2 += (x[j].x * x[j].x + x[j].y * x[j].y) + (x[j].z * x[j].z + x[j].w * x[j].w);
        const float r2 = 1.0f / sqrtf(wave_sum(s2) * (1.0f / DM) + RMS_EPS);
#pragma unroll
        for (int j = 0; j < 16; ++j) { const f32x4 gp = *(const f32x4*)(gpre + 4 * lane + 256 * j);
            v2u o; o.x = pk2(x[j].x * r2 * gp.x, x[j].y * r2 * gp.y); o.y = pk2(x[j].z * r2 * gp.z, x[j].w * r2 * gp.w);
            *(v2u*)(xn + 4 * lane + 256 * j) = o;
            if ((j & 3) == 3) asm volatile("" ::: "memory"); }
    }
}

__device__ __forceinline__ void gains_to_lds(const float* gpost, const float* gpre, LAS float* gl, int lane_, int wid) {
    int lane = lane_; asm volatile("" : "+v"(lane));
    __syncthreads();
#pragma unroll
    for (int q = 0; q < 2; ++q) { const int i = (q * NWAVES + wid) * 64 + lane;
        ((LAS f32x4*)gl)[i] = ((const f32x4*)gpost)[i]; if (gpre) ((LAS f32x4*)gl)[DM / 4 + i] = ((const f32x4*)gpre)[i]; }
    LDS_WAIT();
    __syncthreads();
}
__device__ __forceinline__ void raw_ld(const float* p, f32x4& r) { r = NT_LD((const f32x4*)p); }
__device__ __forceinline__ void raw_ld(const bf16* p, v2u& r) { r = NT_LD((const v2u*)p); }
__device__ __forceinline__ f32x4 raw_cv(const f32x4& r) { return r; }
__device__ __forceinline__ f32x4 raw_cv(const v2u& w) { return (f32x4){bflo(w.x), bfhi(w.x), bflo(w.y), bfhi(w.y)}; }
template <typename T> struct RawOf { typedef f32x4 type; };
template <> struct RawOf<bf16> { typedef v2u type; };
template <typename TI> struct RowRaw { v2u fw[16]; typename RawOf<TI>::type xw[16]; };
template <typename TI>
__device__ __forceinline__ void row_load(const TI* xin, const bf16* f, int lane_, RowRaw<TI>& R) {
    int lane = lane_; asm volatile("" : "+v"(lane));
#pragma unroll
    for (int j = 0; j < 16; ++j) R.fw[j] = NT_LD((const v2u*)(f + 4 * lane + 256 * j));
#pragma unroll
    for (int j = 0; j < 16; ++j) raw_ld(xin + 4 * lane + 256 * j, R.xw[j]);
}
template <typename TI, typename TO, bool HAS_XN>
__device__ __forceinline__ void row_finish(const RowRaw<TI>& R, const LAS float* gl, TO* xout, bf16* xn, int lane_) {
    int lane = lane_; asm volatile("" : "+v"(lane));
    float ss = 0.f;
#pragma unroll
    for (int j = 0; j < 16; ++j) { const float a = bflo(R.fw[j].x), b = bfhi(R.fw[j].x), c = bflo(R.fw[j].y), d = bfhi(R.fw[j].y); ss += (a * a + b * b) + (c * c + d * d); }
    const float r1 = 1.0f / sqrtf(wave_sum(ss) * (1.0f / DM) + RMS_EPS);
    f32x4 x[16]; float s2 = 0.f;
#pragma unroll
    for (int j = 0; j < 16; ++j) { const f32x4 xv = raw_cv(R.xw[j]), gp = *(const LAS f32x4*)(gl + 4 * lane + 256 * j);
        x[j].x = xv.x + bflo(R.fw[j].x) * r1 * gp.x; x[j].y = xv.y + bfhi(R.fw[j].x) * r1 * gp.y; x[j].z = xv.z + bflo(R.fw[j].y) * r1 * gp.z; x[j].w = xv.w + bfhi(R.fw[j].y) * r1 * gp.w;
        st_row4(xout + 4 * lane + 256 * j, x[j]);
        s2 += (x[j].x * x[j].x + x[j].y * x[j].y) + (x[j].z * x[j].z + x[j].w * x[j].w); }
    if (HAS_XN) {
        const float r2 = 1.0f / sqrtf(wave_sum(s2) * (1.0f / DM) + RMS_EPS);
#pragma unroll
        for (int j = 0; j < 16; ++j) { const f32x4 gp = *(const LAS f32x4*)(gl + DM + 4 * lane + 256 * j);
            v2u o; o.x = pk2(x[j].x * r2 * gp.x, x[j].y * r2 * gp.y); o.y = pk2(x[j].z * r2 * gp.z, x[j].w * r2 * gp.w);
            *(v2u*)(xn + 4 * lane + 256 * j) = o; }
    }
}
template <typename TI, typename TO, bool HAS_XN, bool PREFETCH>
__device__ __forceinline__ void row_phase(const TI* xin, const bf16* f, const LAS float* gl, TO* xout, bf16* xn, int gw, int ngw, int nrows, int lane) {
    if (!PREFETCH) {
        for (int m0 = gw; m0 < nrows; m0 += ngw) { const size_t o = (size_t)(m0 % SEQ) * DM; RowRaw<TI> a; row_load(xin + o, f + o, lane, a); asm volatile("" ::: "memory");
            row_finish<TI, TO, HAS_XN>(a, gl, xout + o, xn + o, lane); }
    } else {
        int m0 = gw; if (m0 >= nrows) return;
        RowRaw<TI> a, b; { const size_t o = (size_t)(m0 % SEQ) * DM; row_load(xin + o, f + o, lane, a); }
        for (;;) {
            const int m1 = m0 + ngw; if (m1 < nrows) { const size_t o = (size_t)(m1 % SEQ) * DM; row_load(xin + o, f + o, lane, b); }
            asm volatile("" ::: "memory");
            { const size_t o = (size_t)(m0 % SEQ) * DM; row_finish<TI, TO, HAS_XN>(a, gl, xout + o, xn + o, lane); }
            if (m1 >= nrows) break;
            const int m2 = m1 + ngw; if (m2 < nrows) { const size_t o = (size_t)(m2 % SEQ) * DM; row_load(xin + o, f + o, lane, a); }
            asm volatile("" ::: "memory");
            { const size_t o = (size_t)(m1 % SEQ) * DM; row_finish<TI, TO, HAS_XN>(b, gl, xout + o, xn + o, lane); }
            if (m2 >= nrows) break;
            m0 = m2;
        }
    }
}

__device__ __forceinline__ float dot128(const v4u (&q)[16], const bf16* kp) {
    float s0 = 0.f, s1 = 0.f;
#pragma unroll
    for (int i = 0; i < 16; ++i) { const v4u kv = *(const v4u*)(kp + 8 * i);
        s0 += bflo(q[i].x) * bflo(kv.x) + bflo(q[i].y) * bflo(kv.y) + bflo(q[i].z) * bflo(kv.z) + bflo(q[i].w) * bflo(kv.w);
        s1 += bfhi(q[i].x) * bfhi(kv.x) + bfhi(q[i].y) * bfhi(kv.y) + bfhi(q[i].z) * bfhi(kv.z) + bfhi(q[i].w) * bfhi(kv.w); }
    return s0 + s1;
}
constexpr float SB_STOP_N = -100.0f;
__device__ __forceinline__ void sb_naive(const bf16* P, bf16* OSB, int h, int t, int lane) {
    v4u q[16];
    { const bf16* qp = P + (size_t)t * INW + C_QSB + h * HD;
#pragma unroll
      for (int i = 0; i < 16; ++i) q[i] = *(const v4u*)(qp + 8 * i); }
    float o0 = 0.f, o1 = 0.f, R = 0.f;
    for (int base = t - 1; base >= 0; base -= 64) {
        const int s = base - lane; const bool valid = s >= 0; const int sc = valid ? s : 0;
        const float z = dot128(q, P + (size_t)sc * INW + C_KSB + h * HD) * ATT_SCALE;
        const float sp = fmaxf(z, 0.f) + __logf(1.0f + __expf(-fabsf(z)));
        const float lb = valid ? -sp : 0.f, ls = z - sp;
        float inc = lb;
#pragma unroll
        for (int o = 1; o < 64; o <<= 1) { const float tv = __shfl_up(inc, o); if (lane >= o) inc += tv; }
        const float a = valid ? __expf(ls + R + inc - lb) : 0.f;
        const float tot = __shfl(inc, 63);
        const int nk = base + 1 < 64 ? base + 1 : 64;
        for (int j = 0; j < nk; ++j) { const float aj = __shfl(a, j); const bf16* vp = P + (size_t)(base - j) * INW + C_VSB + h * HD;
            o0 += aj * bf2f(vp[lane]); o1 += aj * bf2f(vp[lane + 64]); }
        R += tot;
        if (R < SB_STOP_N) break;
    }
    bf16* op = OSB + (size_t)t * SBW + h * HD;
    op[lane] = (bf16)(pk2(o0, 0.f) & 0xffffu); op[lane + 64] = (bf16)(pk2(o1, 0.f) & 0xffffu);
}
__device__ __forceinline__ void dl_naive(const bf16* P, bf16* ODL, int h, int t, int lane) {
    v4u q[16];
    { const bf16* qp = P + (size_t)t * INW + C_QDL + h * HD;
#pragma unroll
      for (int i = 0; i < 16; ++i) q[i] = *(const v4u*)(qp + 8 * i); }
    float o0 = 0.f, o1 = 0.f, m = -1e30f, l = 0.f;
    for (int b = 0; b < 3; ++b) { const int d = b == 0 ? 1 : (b == 1 ? 4 : 16);
        for (int it = 0; it < 3; ++it) {
            const int j = it * 64 + lane, pos = t - j * d; const bool valid = (j <= 128) && (pos >= 0); const int pc = valid ? pos : 0;
            if (t - it * 64 * d < 0) break;
            const float s = dot128(q, P + (size_t)pc * INW + C_KDL + h * HD) * ATT_SCALE;
            const float tm = wave_max(valid ? s : -1e30f);
            const float mn = fmaxf(m, tm), alpha = __expf(m - mn);
            const float p = valid ? __expf(s - mn) : 0.f;
            l = l * alpha + wave_sum(p); o0 *= alpha; o1 *= alpha; m = mn;
            const int nj = it == 2 ? 1 : 64;
            for (int jj = 0; jj < nj; ++jj) { const int pp = t - (it * 64 + jj) * d; if (pp < 0) break;
                const float pj = __shfl(p, jj); const bf16* vp = P + (size_t)pp * INW + C_VDL + h * HD;
                o0 += pj * bf2f(vp[lane]); o1 += pj * bf2f(vp[lane + 64]); }
        }
    }
    const float rl = 1.0f / l;
    bf16* op = ODL + (size_t)t * DLW + h * HD;
    op[lane] = (bf16)(pk2(o0 * rl, 0.f) & 0xffffu); op[lane + 64] = (bf16)(pk2(o1 * rl, 0.f) & 0xffffu);
}

#ifndef EXP_OLDSSM
#define EXP_OLDSSM 0
#endif
#ifndef EXP_MFMA_PAD
#define EXP_MFMA_PAD 0
#endif
#ifndef EXP_UGLOBAL
#define EXP_UGLOBAL 0
#endif
struct SsmW { const float *lam_re, *lam_im, *log_dt, *b_re, *b_im, *c_re, *c_im, *dsk; };
struct SsmRegs { float ar, ai, atr, ati, dsk; bf16x8 bfr[8]; bf16x8 cf[4]; };
template <bool PASS2>
__device__ __forceinline__ void ssm_build(const SsmW& w, int g, int lane_, SsmRegs& R) {
    int lane = lane_; asm volatile("" : "+v"(lane));
    const float a_re = fminf(w.lam_re[g * NST + lane], -1e-4f), a_im = w.lam_im[g * NST + lane], dt = expf(w.log_dt[g]);
    const float mag = expf(dt * a_re), ang = dt * a_im;
    const float ar = mag * cosf(ang), ai = mag * sinf(ang);
    const float den = a_re * a_re + a_im * a_im, nr = ar - 1.0f;
    const float f_re = (nr * a_re + ai * a_im) / den, f_im = (ai * a_re - nr * a_im) / den;
    R.ar = ar; R.ai = ai;
    float tr = ar, ti = ai;
#pragma unroll
    for (int s = 0; s < 7; ++s) { const float n2r = tr * tr - ti * ti, n2i = 2.0f * tr * ti; tr = n2r; ti = n2i; }
    R.atr = tr; R.ati = ti;
    const int n16 = lane & 15, kq = lane >> 4;
#pragma unroll
    for (int j = 0; j < 8; ++j) { const int np = (16 * j + n16) & 63; const float fr = __shfl(f_re, np), fi = __shfl(f_im, np);
        const float* brp = w.b_re + (size_t)(g * NST + np) * SGRP + 8 * (kq & 1); const float* bip = w.b_im + (size_t)(g * NST + np) * SGRP + 8 * (kq & 1);
        const f32x4 r0 = *(const f32x4*)brp, r1 = *(const f32x4*)(brp + 4), i0 = *(const f32x4*)bip, i1 = *(const f32x4*)(bip + 4);
        float v[8];
#pragma unroll
        for (int e = 0; e < 4; ++e) { v[e] = j < 4 ? fr * r0[e] - fi * i0[e] : fr * i0[e] + fi * r0[e]; v[4 + e] = j < 4 ? fr * r1[e] - fi * i1[e] : fr * i1[e] + fi * r1[e]; }
        v4u o; o.x = pk2(v[0], v[1]); o.y = pk2(v[2], v[3]); o.z = pk2(v[4], v[5]); o.w = pk2(v[6], v[7]);
        if (kq >= 2) o = (v4u){0u, 0u, 0u, 0u};
        R.bfr[j] = __builtin_bit_cast(bf16x8, o); }
    if (PASS2) {
#pragma unroll
        for (int kk = 0; kk < 4; ++kk) { const float* src = (kk < 2 ? w.c_re : w.c_im) + (size_t)(g * SGRP + n16) * NST + (kk & 1) * 32 + 8 * kq;
            const f32x4 v0 = *(const f32x4*)src, v1 = *(const f32x4*)(src + 4); const float sg = kk < 2 ? 1.0f : -1.0f;
            v4u o; o.x = pk2(sg * v0.x, sg * v0.y); o.y = pk2(sg * v0.z, sg * v0.w); o.z = pk2(sg * v1.x, sg * v1.y); o.w = pk2(sg * v1.z, sg * v1.w);
            R.cf[kk] = __builtin_bit_cast(bf16x8, o); }
        R.dsk = w.dsk[g * SGRP + n16];
    }
}
constexpr int BU_PITCH = 20;
template <bool PASS2>
__device__ __forceinline__ void ssm_unit(const bf16* P, const SsmW& w, float* xe, bf16* Gout, int g, int ch, LAS unsigned char* wl, int lane_) {
    int lane = lane_; asm volatile("" : "+v"(lane));
    const int tb = ch * SSM_T;
    LAS float* BU = (LAS float*)wl;
    LAS bf16* X = (LAS bf16*)(wl + 128 * BU_PITCH * 4);
    LAS bf16* UA = (LAS bf16*)(wl + 128 * BU_PITCH * 4 + 4096);
    {
        const bf16* src = P + (size_t)(tb + (lane >> 1)) * INW + C_USSM + g * SGRP + 8 * (lane & 1);
        v4u s4[4];
#pragma unroll
        for (int q = 0; q < 4; ++q) s4[q] = *(const v4u*)(src + (size_t)q * 32 * INW);
#pragma unroll
        for (int q = 0; q < 4; ++q) *(LAS v4u*)(UA + (q * 32 + (lane >> 1)) * 16 + 8 * (lane & 1)) = s4[q];
    }
    SsmRegs R; ssm_build<PASS2>(w, g, lane, R);
    const int n16 = lane & 15, kq = lane >> 4;
    const float ar = R.ar, ai = R.ai;
    float xr = 0.f, xi = 0.f;
    if (PASS2) {
        for (int j0 = 0; j0 < ch; j0 += 16) { f32x2 e[16];
#pragma unroll
            for (int q = 0; q < 16; ++q) { const int j = j0 + q < ch ? j0 + q : ch - 1; e[q] = *(const f32x2*)(xe + ((size_t)(j * NGRP + g) * NST + lane) * 2); }
#pragma unroll
            for (int q = 0; q < 16; ++q) if (j0 + q < ch) { const float nr = R.atr * xr - R.ati * xi + e[q].x, ni = R.atr * xi + R.ati * xr + e[q].y; xr = nr; xi = ni; } }
    }
    VM_WAIT(); LDS_WAIT(); asm volatile("" ::: "memory");
    for (int blk = 0; blk < SSM_T / 16; ++blk) {
        v4u aw = *(const LAS v4u*)(UA + (blk * 16 + n16) * 16 + 8 * (kq & 1));
        LDS_WAIT(); asm volatile("" ::: "memory");
        if (kq >= 2) aw = (v4u){0u, 0u, 0u, 0u};
        const bf16x8 af = __builtin_bit_cast(bf16x8, aw);
        f32x4 dd[8];
#pragma unroll
        for (int j = 0; j < 8; ++j) dd[j] = __builtin_amdgcn_mfma_f32_16x16x32_bf16(af, R.bfr[j], (f32x4){0.f, 0.f, 0.f, 0.f}, 0, 0, 0);
        asm volatile("" : "+v"(dd[0]), "+v"(dd[1]), "+v"(dd[2]), "+v"(dd[3]), "+v"(dd[4]), "+v"(dd[5]), "+v"(dd[6]), "+v"(dd[7]));
#pragma unroll
        for (int j = 0; j < 8; ++j) *(LAS f32x4*)(BU + (16 * j + n16) * BU_PITCH + 4 * kq) = dd[j];
        LDS_WAIT(); asm volatile("" ::: "memory");
        f32x4 br[4], bi[4];
#pragma unroll
        for (int q = 0; q < 4; ++q) { br[q] = *(const LAS f32x4*)(BU + lane * BU_PITCH + 4 * q); bi[q] = *(const LAS f32x4*)(BU + (64 + lane) * BU_PITCH + 4 * q); }
        LDS_WAIT(); asm volatile("" ::: "memory");
#pragma unroll
        for (int tt = 0; tt < 16; ++tt) { const float nr = ar * xr - ai * xi + br[tt >> 2][tt & 3], ni = ar * xi + ai * xr + bi[tt >> 2][tt & 3]; xr = nr; xi = ni;
            if (PASS2) { const unsigned pkx = pk2(xr, xi); X[tt * 128 + lane] = (bf16)(pkx & 0xffffu); X[tt * 128 + 64 + lane] = (bf16)(pkx >> 16);
                if ((tt & 3) == 3) { LDS_WAIT(); asm volatile("" ::: "memory"); } } }
        if (PASS2) {
            LDS_WAIT(); asm volatile("" ::: "memory");
            f32x4 acc = (f32x4){0.f, 0.f, 0.f, 0.f};
            bf16x8 xf[4];
#pragma unroll
            for (int kk = 0; kk < 4; ++kk) xf[kk] = *(const LAS bf16x8*)((LAS unsigned char*)X + n16 * 256 + kk * 64 + kq * 16);
            bf16 uu[4];
#pragma unroll
            for (int r = 0; r < 4; ++r) uu[r] = UA[(blk * 16 + 4 * kq + r) * 16 + n16];
            LDS_WAIT(); asm volatile("" ::: "memory");
#pragma unroll
            for (int kk = 0; kk < 4; ++kk) acc = __builtin_amdgcn_mfma_f32_16x16x32_bf16(xf[kk], R.cf[kk], acc, 0, 0, 0);
#pragma unroll
            for (int r = 0; r < 4; ++r) { const float u = bf2f(uu[r]);
                const float y = acc[r] + R.dsk * u;
                const float th = 1.0f - 2.0f * __builtin_amdgcn_rcpf(1.0f + __expf(2.0f * 0.7978845608028654f * (y + 0.044715f * y * y * y)));
                UA[(blk * 16 + 4 * kq + r) * 16 + n16] = (bf16)(pk2(0.5f * y * (1.0f + th), 0.f) & 0xffffu); }
        }
        LDS_WAIT(); asm volatile("" ::: "memory");
    }
    if (PASS2) {
        v4u o4[4];
#pragma unroll
        for (int q = 0; q < 4; ++q) o4[q] = *(const LAS v4u*)(UA + (q * 32 + (lane >> 1)) * 16 + 8 * (lane & 1));
        LDS_WAIT(); asm volatile("" ::: "memory");
        bf16* dst = Gout + (size_t)(tb + (lane >> 1)) * SSMC + g * SGRP + 8 * (lane & 1);
#pragma unroll
        for (int q = 0; q < 4; ++q) *(v4u*)(dst + (size_t)q * 32 * SSMC) = o4[q];
    }
    if (!PASS2) *(f32x2*)(xe + ((size_t)(ch * NGRP + g) * NST + lane) * 2) = (f32x2){xr, xi};
}

#if EXP_OLDSSM
struct SsmWOld { const float *lam_re, *lam_im, *log_dt, *b_re, *b_im, *c_re, *c_im, *dsk; };
__device__ __forceinline__ void ssm_params_old(const SsmWOld& w, int g, int n, float& ar, float& ai, float (&bre)[16], float (&bim)[16]) {
    const float a_re = fminf(w.lam_re[g * NST + n], -1e-4f), a_im = w.lam_im[g * NST + n], dt = expf(w.log_dt[g]);
    const float mag = expf(dt * a_re), ang = dt * a_im;
    ar = mag * cosf(ang); ai = mag * sinf(ang);
    const float den = a_re * a_re + a_im * a_im, nr = ar - 1.0f;
    const float f_re = (nr * a_re + ai * a_im) / den, f_im = (ai * a_re - nr * a_im) / den;
#pragma unroll
    for (int c4 = 0; c4 < 4; ++c4) { const f32x4 br = *(const f32x4*)(w.b_re + (size_t)(g * NST + n) * SGRP + 4 * c4), bi = *(const f32x4*)(w.b_im + (size_t)(g * NST + n) * SGRP + 4 * c4);
#pragma unroll
        for (int e = 0; e < 4; ++e) { bre[4 * c4 + e] = f_re * br[e] - f_im * bi[e]; bim[4 * c4 + e] = f_re * bi[e] + f_im * br[e]; } }
}
__device__ __forceinline__ void ssm_stage_u_old(const bf16* P, int g, int tb, LAS unsigned char* wl, int lane) {
#pragma unroll
    for (int rr = 0; rr < 2; ++rr) { const int t = 2 * lane + rr; const bf16* up = P + (size_t)(tb + t) * INW + C_USSM + g * SGRP;
        const v4u a = *(const v4u*)up, b = *(const v4u*)(up + 8);
        LAS f32x4* d = (LAS f32x4*)(wl + t * 64);
        d[0] = (f32x4){bflo(a.x), bfhi(a.x), bflo(a.y), bfhi(a.y)}; d[1] = (f32x4){bflo(a.z), bfhi(a.z), bflo(a.w), bfhi(a.w)};
        d[2] = (f32x4){bflo(b.x), bfhi(b.x), bflo(b.y), bfhi(b.y)}; d[3] = (f32x4){bflo(b.z), bfhi(b.z), bflo(b.w), bfhi(b.w)}; }
    LDS_WAIT(); asm volatile("" ::: "memory");
}
__device__ __forceinline__ void ssm_step_old(const LAS unsigned char* wl, int t, float ar, float ai, const float (&bre)[16], const float (&bim)[16], float& xr, float& xi) {
    const LAS f32x4* up = (const LAS f32x4*)(wl + t * 64);
    float br = 0.f, bi = 0.f;
#pragma unroll
    for (int c4 = 0; c4 < 4; ++c4) { const f32x4 u = up[c4];
#pragma unroll
        for (int e = 0; e < 4; ++e) { br += bre[4 * c4 + e] * u[e]; bi += bim[4 * c4 + e] * u[e]; } }
    const float nr = ar * xr - ai * xi + br, ni = ar * xi + ai * xr + bi; xr = nr; xi = ni;
}
__device__ __forceinline__ void ssm_pass1_old(const bf16* P, const SsmWOld& w, float* xe, int g, int ch, LAS unsigned char* wl, int lane_) {
    int lane = lane_; asm volatile("" : "+v"(lane));
    float ar, ai, bre[16], bim[16]; ssm_params_old(w, g, lane, ar, ai, bre, bim);
    ssm_stage_u_old(P, g, ch * SSM_T, wl, lane);
    float xr = 0.f, xi = 0.f;
    for (int t = 0; t < SSM_T; ++t) ssm_step_old(wl, t, ar, ai, bre, bim, xr, xi);
    *(f32x2*)(xe + ((size_t)(ch * NGRP + g) * NST + lane) * 2) = (f32x2){xr, xi};
    LDS_WAIT(); asm volatile("" ::: "memory");
}
__device__ __forceinline__ void ssm_pass2_old(const bf16* P, const SsmWOld& w, const float* xe, bf16* Gout, int g, int ch, LAS unsigned char* wl, int lane_) {
    int lane = lane_; asm volatile("" : "+v"(lane));
    float ar, ai, bre[16], bim[16]; ssm_params_old(w, g, lane, ar, ai, bre, bim);
    float tr = ar, ti = ai;
#pragma unroll
    for (int s = 0; s < 7; ++s) { const float nr = tr * tr - ti * ti, ni = 2.0f * tr * ti; tr = nr; ti = ni; }
    float xr = 0.f, xi = 0.f;
    for (int j = 0; j < ch; ++j) { const f32x2 e = *(const f32x2*)(xe + ((size_t)(j * NGRP + g) * NST + lane) * 2);
        const float nr = tr * xr - ti * xi + e.x, ni = tr * xi + ti * xr + e.y; xr = nr; xi = ni; }
    const int tb = ch * SSM_T;
    ssm_stage_u_old(P, g, tb, wl, lane);
    const int c = lane & 15, kq = lane >> 4;
    bf16x8 cf[4];
#pragma unroll
    for (int kk = 0; kk < 4; ++kk) { const float* src = (kk < 2 ? w.c_re : w.c_im) + (size_t)(g * SGRP + c) * NST + (kk & 1) * 32 + 8 * kq;
        const f32x4 v0 = *(const f32x4*)src, v1 = *(const f32x4*)(src + 4); const float sg = kk < 2 ? 1.0f : -1.0f;
        v4u pkd; pkd.x = pk2(sg * v0.x, sg * v0.y); pkd.y = pk2(sg * v0.z, sg * v0.w); pkd.z = pk2(sg * v1.x, sg * v1.y); pkd.w = pk2(sg * v1.z, sg * v1.w);
        cf[kk] = __builtin_bit_cast(bf16x8, pkd); }
    const float dsk = w.dsk[g * SGRP + c];
    LAS bf16* X = (LAS bf16*)(wl + 8192);
    for (int blk = 0; blk < SSM_T / 16; ++blk) {
#pragma unroll 4
        for (int tt = 0; tt < 16; ++tt) { ssm_step_old(wl, blk * 16 + tt, ar, ai, bre, bim, xr, xi);
            const unsigned pkx = pk2(xr, xi); X[tt * 128 + lane] = (bf16)(pkx & 0xffffu); X[tt * 128 + 64 + lane] = (bf16)(pkx >> 16); }
        LDS_WAIT(); asm volatile("" ::: "memory");
        f32x4 acc = (f32x4){0.f, 0.f, 0.f, 0.f};
#pragma unroll
        for (int kk = 0; kk < 4; ++kk) { const bf16x8 af = *(const LAS bf16x8*)(wl + 8192 + c * 256 + kk * 64 + kq * 16);
            acc = __builtin_amdgcn_mfma_f32_16x16x32_bf16(af, cf[kk], acc, 0, 0, 0); }
#pragma unroll
        for (int r = 0; r < 4; ++r) { const int t = blk * 16 + 4 * kq + r;
#if EXP_UGLOBAL
            const float u = bf2f(P[(size_t)(tb + t) * INW + C_USSM + g * SGRP + c]);
#else
            const float u = ((const LAS float*)wl)[t * 16 + c];
#endif

            const float y = acc[r] + dsk * u;
            const float th = 1.0f - 2.0f * __builtin_amdgcn_rcpf(1.0f + __expf(2.0f * 0.7978845608028654f * (y + 0.044715f * y * y * y)));
            const float gl = 0.5f * y * (1.0f + th);
            Gout[(size_t)(tb + t) * SSMC + g * SGRP + c] = (bf16)(pk2(gl, 0.f) & 0xffffu); }
        LDS_WAIT(); asm volatile("" ::: "memory");
    }
}

#endif
template <int NCH>
__device__ __forceinline__ void seg_norm(const bf16* src, const float* gain, bf16* dst, int lane_) {
    int lane = lane_; asm volatile("" : "+v"(lane));
    v4u a[NCH]; float ss = 0.f;
#pragma unroll
    for (int i = 0; i < NCH; ++i) { a[i] = *(const v4u*)(src + 8 * lane + 512 * i);
        ss += (bflo(a[i].x) * bflo(a[i].x) + bfhi(a[i].x) * bfhi(a[i].x)) + (bflo(a[i].y) * bflo(a[i].y) + bfhi(a[i].y) * bfhi(a[i].y))
            + (bflo(a[i].z) * bflo(a[i].z) + bfhi(a[i].z) * bfhi(a[i].z)) + (bflo(a[i].w) * bflo(a[i].w) + bfhi(a[i].w) * bfhi(a[i].w)); }
    const float r = 1.0f / sqrtf(wave_sum(ss) * (1.0f / (NCH * 512)) + RMS_EPS);
#pragma unroll
    for (int i = 0; i < NCH; ++i) { const f32x4 g0 = *(const f32x4*)(gain + 8 * lane + 512 * i), g1 = *(const f32x4*)(gain + 8 * lane + 512 * i + 4);
        v4u o; o.x = pk2(bflo(a[i].x) * r * g0.x, bfhi(a[i].x) * r * g0.y); o.y = pk2(bflo(a[i].y) * r * g0.z, bfhi(a[i].y) * r * g0.w);
        o.z = pk2(bflo(a[i].z) * r * g1.x, bfhi(a[i].z) * r * g1.y); o.w = pk2(bflo(a[i].w) * r * g1.z, bfhi(a[i].w) * r * g1.w);
        *(v4u*)(dst + 8 * lane + 512 * i) = o; }
}


typedef float f32x16 __attribute__((ext_vector_type(16)));
typedef short s16x4 __attribute__((ext_vector_type(4)));
__device__ __forceinline__ int crow(int r, int hi) { return (r & 3) + 8 * (r >> 2) + 4 * hi; }
__device__ __forceinline__ int v_st(int k, int c) { const int kk = (k & ~0xC) | ((k & 4) << 1) | ((k & 8) >> 1); return ((kk >> 3) * 4 + (c >> 5)) * 512 + ((kk & 7) * 32 + (c & 31)) * 2; }
__device__ __forceinline__ int v_rd_base(int lane) { return ((lane & 3) << 3) | (((lane >> 2) & 3) << 6) | (((lane >> 4) & 1) << 5) | (((lane >> 5) & 1) << 8); }
constexpr int v_rd_off(int d0, int ks, int half) { return d0 * 512 + ks * 4096 + half * 2048; }
template <int OFF> __device__ __forceinline__ s16x4 tr_read(int vb) {
    s16x4 r; asm volatile("ds_read_b64_tr_b16 %0, %1 offset:%2" : "=&v"(r) : "v"(vb), "i"(OFF) : "memory"); return r;
}
template <int D0> __device__ __forceinline__ void pv_one(f32x16& od, int vb, bf16x8 pa0, bf16x8 pa1, bf16x8 pa2, bf16x8 pa3) {
    const s16x4 l0 = tr_read<v_rd_off(D0, 0, 0)>(vb), h0 = tr_read<v_rd_off(D0, 0, 1)>(vb), l1 = tr_read<v_rd_off(D0, 1, 0)>(vb), h1 = tr_read<v_rd_off(D0, 1, 1)>(vb);
    const s16x4 l2 = tr_read<v_rd_off(D0, 2, 0)>(vb), h2 = tr_read<v_rd_off(D0, 2, 1)>(vb), l3 = tr_read<v_rd_off(D0, 3, 0)>(vb), h3 = tr_read<v_rd_off(D0, 3, 1)>(vb);
    asm volatile("s_waitcnt lgkmcnt(0)" ::: "memory"); __builtin_amdgcn_sched_barrier(0);
#define PKV(L, H) (bf16x8){L[0], L[1], L[2], L[3], H[0], H[1], H[2], H[3]}
    od = __builtin_amdgcn_mfma_f32_32x32x16_bf16(pa0, PKV(l0, h0), od, 0, 0, 0);
    od = __builtin_amdgcn_mfma_f32_32x32x16_bf16(pa1, PKV(l1, h1), od, 0, 0, 0);
    od = __builtin_amdgcn_mfma_f32_32x32x16_bf16(pa2, PKV(l2, h2), od, 0, 0, 0);
    od = __builtin_amdgcn_mfma_f32_32x32x16_bf16(pa3, PKV(l3, h3), od, 0, 0, 0);
#undef PKV
}
__device__ __forceinline__ void pack_p(const f32x16& p0, const f32x16& p1, bf16x8& pa0, bf16x8& pa1, bf16x8& pa2, bf16x8& pa3) {
#define PK4(P, BASE, OUT) do { const unsigned a0 = pk2(P[BASE + 0], P[BASE + 1]), a1 = pk2(P[BASE + 2], P[BASE + 3]), b0 = pk2(P[BASE + 4], P[BASE + 5]), b1 = pk2(P[BASE + 6], P[BASE + 7]); \
        const auto r0 = __builtin_amdgcn_permlane32_swap(a0, b0, false, false); const auto r1 = __builtin_amdgcn_permlane32_swap(a1, b1, false, false); \
        v4u w = {r0[0], r1[0], r0[1], r1[1]}; OUT = __builtin_bit_cast(bf16x8, w); } while (0)
    PK4(p0, 0, pa0); PK4(p0, 8, pa1); PK4(p1, 0, pa2); PK4(p1, 8, pa3);
#undef PK4
}
#ifndef K_VIA_LDS
#define K_VIA_LDS 1
#endif
#ifndef V_FIRST_N
#define V_FIRST_N 5
#endif
constexpr int V_FIRST = V_FIRST_N;
struct VPend { v4u vv[16 - V_FIRST]; };
__device__ __forceinline__ void tile_qk(const bf16* P, int rowb, int rstride, int kcol, int vcol, const bf16x8 (&qr)[8], LAS unsigned char* wl, int lane, f32x16& p0, f32x16& p1, VPend& pend) {
    const int r32 = lane & 31, hi = lane >> 5, lq = lane >> 4, c = (lane & 15) * 8;
    const unsigned voff = (unsigned)(lq * rstride) * INW + vcol + c;
    LAS unsigned char* const vdst = wl + (c >> 5) * 512 + (lq * 32 + (c & 31)) * 2;
#if K_VIA_LDS
    const unsigned koff = (unsigned)(lq * rstride) * INW + kcol + c;
    v4u kw[16];
#pragma unroll
    for (int j = 0; j < 16; ++j) { const bf16* rowp = P + (size_t)(rowb + 4 * j * rstride) * INW; kw[j] = *(const v4u*)(rowp + koff); }
    v4u va[V_FIRST];
#pragma unroll
    for (int j = 0; j < V_FIRST; ++j) { const bf16* rowp = P + (size_t)(rowb + 4 * j * rstride) * INW; va[j] = *(const v4u*)(rowp + voff); }
    asm volatile("" ::: "memory");
    { LAS unsigned char* const kdst = wl + lq * 272 + (lane & 15) * 16;
#pragma unroll
      for (int j = 0; j < 16; ++j) *(LAS v4u*)(kdst + j * 4 * 272) = kw[j]; }
    LDS_WAIT(); asm volatile("" ::: "memory");
    bf16x8 kf0[8], kf1[8];
    { const LAS unsigned char* const ksrc = wl + r32 * 272 + hi * 16;
#pragma unroll
      for (int d0 = 0; d0 < 8; ++d0) { kf0[d0] = *(const LAS bf16x8*)(ksrc + d0 * 32); kf1[d0] = *(const LAS bf16x8*)(ksrc + 32 * 272 + d0 * 32); } }
    LDS_WAIT(); asm volatile("" ::: "memory");
#else
    const bf16* const k0p = P + (size_t)rowb * INW; const bf16* const k1p = P + (size_t)(rowb + 32 * rstride) * INW;
    const unsigned koff = (unsigned)(r32 * rstride) * INW + kcol + hi * 8;
    bf16x8 kf0[8], kf1[8];
#pragma unroll
    for (int d0 = 0; d0 < 8; ++d0) { kf0[d0] = *(const bf16x8*)(k0p + koff + d0 * 16); kf1[d0] = *(const bf16x8*)(k1p + koff + d0 * 16); }
    v4u va[V_FIRST];
#pragma unroll
    for (int j = 0; j < V_FIRST; ++j) { const bf16* rowp = P + (size_t)(rowb + 4 * j * rstride) * INW; va[j] = *(const v4u*)(rowp + voff); }
    asm volatile("" ::: "memory");
#endif
    p0 = (f32x16){}; p1 = (f32x16){};
#pragma unroll
    for (int d0 = 0; d0 < 8; ++d0) { p0 = __builtin_amdgcn_mfma_f32_32x32x16_bf16(kf0[d0], qr[d0], p0, 0, 0, 0); p1 = __builtin_amdgcn_mfma_f32_32x32x16_bf16(kf1[d0], qr[d0], p1, 0, 0, 0); }
#pragma unroll
    for (int j = 0; j < V_FIRST; ++j) *(LAS v4u*)(vdst + ((j & 1) + 2 * (j >> 2)) * 2048 + ((j >> 1) & 1) * 256) = va[j];
#pragma unroll
    for (int j = V_FIRST; j < 16; ++j) { const bf16* rowp = P + (size_t)(rowb + 4 * j * rstride) * INW; pend.vv[j - V_FIRST] = *(const v4u*)(rowp + voff); }
    asm volatile("" ::: "memory");
}
__device__ __forceinline__ void tile_v_finish(LAS unsigned char* wl, int lane, const VPend& pend) {
    const int lq = lane >> 4, c = (lane & 15) * 8;
    LAS unsigned char* const vdst = wl + (c >> 5) * 512 + (lq * 32 + (c & 31)) * 2;
#pragma unroll
    for (int j = V_FIRST; j < 16; ++j) *(LAS v4u*)(vdst + ((j & 1) + 2 * (j >> 2)) * 2048 + ((j >> 1) & 1) * 256) = pend.vv[j - V_FIRST];
}
__device__ __forceinline__ void strip_q(const bf16* P, int qrow0, int qstride, int qcol, LAS unsigned char* wl, int lane, bf16x8 (&qr)[8]) {
    const int r32 = lane & 31, hi = lane >> 5, lq = lane >> 4;
    const unsigned qoff = (unsigned)(lq * qstride) * INW + qcol + (lane & 15) * 8;
    v4u qw[8];
#pragma unroll
    for (int j = 0; j < 8; ++j) { const bf16* rowp = P + (size_t)(qrow0 + 4 * j * qstride) * INW; qw[j] = *(const v4u*)(rowp + qoff); }
    { LAS unsigned char* const qdst = wl + lq * 272 + (lane & 15) * 16;
#pragma unroll
      for (int j = 0; j < 8; ++j) *(LAS v4u*)(qdst + j * 4 * 272) = qw[j]; }
    LDS_WAIT(); asm volatile("" ::: "memory");
    { const LAS unsigned char* const qsrc = wl + r32 * 272 + hi * 16;
#pragma unroll
      for (int d0 = 0; d0 < 8; ++d0) qr[d0] = *(const LAS bf16x8*)(qsrc + d0 * 32); }
    LDS_WAIT(); asm volatile("" ::: "memory");
}
__device__ __forceinline__ void strip_o_store(bf16* O, int orow0, int ostride, int ldo, int ocol, LAS unsigned char* wl, int lane) {
    const int lq = lane >> 4;
    LDS_WAIT(); asm volatile("" ::: "memory");
    v4u ow[8];
    { const LAS unsigned char* const osrc = wl + lq * 272 + (lane & 15) * 16;
#pragma unroll
      for (int j = 0; j < 8; ++j) ow[j] = *(const LAS v4u*)(osrc + j * 4 * 272); }
    LDS_WAIT(); asm volatile("" ::: "memory");
    const unsigned ooff = (unsigned)(lq * ostride) * ldo + ocol + (lane & 15) * 8;
#pragma unroll
    for (int j = 0; j < 8; ++j) { bf16* rowp = O + (size_t)(orow0 + 4 * j * ostride) * ldo; *(v4u*)(rowp + ooff) = ow[j]; }
}
constexpr float SB_STOP = 1e-37f;
__device__ __forceinline__ void sb_strip(const bf16* P, bf16* OSB, int h, int t0, LAS unsigned char* wl, int lane_) {
    int lane = lane_; asm volatile("" : "+v"(lane));
    const int r32 = lane & 31, hi = lane >> 5;
    bf16x8 qr[8];
    strip_q(P, t0, 1, C_QSB + h * HD, wl, lane, qr);
    f32x16 o[4] = {}; float R = 1.f;
    const int vb = (int)(uintptr_t)wl + v_rd_base(lane);
    const int tq = t0 + r32;
    for (int jt = t0 >> 6; jt >= 0; --jt) {
        const int kb = jt * 64;
        f32x16 p0, p1;
        VPend pend; tile_qk(P, kb, 1, C_KSB + h * HD, C_VSB + h * HD, qr, wl, lane, p0, p1, pend);
#pragma unroll
        for (int r = 0; r < 16; ++r) {
            { const float z = fminf(fmaxf(p0[r] * ATT_SCALE, -80.f), 80.f), q = __builtin_amdgcn_rcpf(1.0f + __expf(z)); p0[r] = (kb + crow(r, hi) < tq) ? q : 1.0f; }
            { const float z = fminf(fmaxf(p1[r] * ATT_SCALE, -80.f), 80.f), q = __builtin_amdgcn_rcpf(1.0f + __expf(z)); p1[r] = (kb + 32 + crow(r, hi) < tq) ? q : 1.0f; }
        }
        float G0[4], G1[4], Q0[4], Q1[4];
#pragma unroll
        for (int q = 0; q < 4; ++q) { G0[q] = (p0[4 * q] * p0[4 * q + 1]) * (p0[4 * q + 2] * p0[4 * q + 3]); G1[q] = (p1[4 * q] * p1[4 * q + 1]) * (p1[4 * q + 2] * p1[4 * q + 3]);
            Q0[q] = __shfl_xor(G0[q], 32); Q1[q] = __shfl_xor(G1[q], 32); }
        float run = 1.f, S0[4], S1[4];
#pragma unroll
        for (int q = 3; q >= 0; --q) { S1[q] = hi == 0 ? run * Q1[q] : run; run *= G1[q] * Q1[q]; }
#pragma unroll
        for (int q = 3; q >= 0; --q) { S0[q] = hi == 0 ? run * Q0[q] : run; run *= G0[q] * Q0[q]; }
#pragma unroll
        for (int q = 0; q < 4; ++q) {
            float e1 = R * S1[q], e0 = R * S0[q];
#pragma unroll
            for (int i = 3; i >= 0; --i) { const int r = 4 * q + i;
                { const float qq = p1[r]; p1[r] = (1.0f - qq) * e1; e1 *= qq; }
                { const float qq = p0[r]; p0[r] = (1.0f - qq) * e0; e0 *= qq; } }
        }
        R *= run;
        tile_v_finish(wl, lane, pend);
        bf16x8 pa0, pa1, pa2, pa3; pack_p(p0, p1, pa0, pa1, pa2, pa3);
        pv_one<0>(o[0], vb, pa0, pa1, pa2, pa3); pv_one<1>(o[1], vb, pa0, pa1, pa2, pa3); pv_one<2>(o[2], vb, pa0, pa1, pa2, pa3); pv_one<3>(o[3], vb, pa0, pa1, pa2, pa3);
        if (__all(R < SB_STOP)) break;
    }
    asm volatile("s_nop 15\n\ts_nop 15" : "+v"(o[0]), "+v"(o[1]), "+v"(o[2]), "+v"(o[3]));
    { LAS unsigned char* const odst = wl + (4 * hi) * 272 + r32 * 2;
#pragma unroll
      for (int r = 0; r < 16; ++r)
#pragma unroll
        for (int d0 = 0; d0 < 4; ++d0) *(LAS bf16*)(odst + ((r & 3) + 8 * (r >> 2)) * 272 + d0 * 64) = (bf16)(pk2(o[d0][r], 0.f) & 0xffffu); }
    strip_o_store(OSB, t0, 1, SBW, h * HD, wl, lane);
}
__device__ __forceinline__ void dl_strip(const bf16* P, bf16* OB, float* ST, int h, int d, int rr, int i0, LAS unsigned char* wl, int lane_) {
    int lane = lane_; asm volatile("" : "+v"(lane));
    const int r32 = lane & 31, hi = lane >> 5;
    bf16x8 qr[8];
    strip_q(P, i0 * d + rr, d, C_QDL + h * HD, wl, lane, qr);
    f32x16 o[4] = {}; float m = -1e30f, l = 0.f;
    const int vb = (int)(uintptr_t)wl + v_rd_base(lane);
    LAS float* al_l = (LAS float*)(wl + 17408);
    const int iq = i0 + r32;
    const int jlo = i0 >= 128 ? (i0 - 128) >> 6 : 0, jhi = (i0 + 31) >> 6;
    for (int jt = jlo; jt <= jhi; ++jt) {
        const int kb = jt * 64;
        f32x16 p0, p1;
        VPend pend; tile_qk(P, kb * d + rr, d, C_KDL + h * HD, C_VDL + h * HD, qr, wl, lane, p0, p1, pend);
        constexpr float C2 = ATT_SCALE * 1.4426950408889634f;
        float tmax = -3e38f;
#pragma unroll
        for (int r = 0; r < 16; ++r) {
            { const unsigned rel = (unsigned)(iq - (kb + crow(r, hi))); p0[r] = rel <= 128u ? p0[r] : -3e38f; tmax = fmaxf(tmax, p0[r]); }
            { const unsigned rel = (unsigned)(iq - (kb + 32 + crow(r, hi))); p1[r] = rel <= 128u ? p1[r] : -3e38f; tmax = fmaxf(tmax, p1[r]); }
        }
        tmax = fmaxf(tmax, __shfl_xor(tmax, 32));
        const float mn = fmaxf(m, tmax), alpha = __builtin_amdgcn_exp2f((m - mn) * C2), mnc = -mn * C2;
        float ps = 0.f;
#pragma unroll
        for (int r = 0; r < 16; ++r) { p0[r] = __builtin_amdgcn_exp2f(fmaf(p0[r], C2, mnc)); p1[r] = __builtin_amdgcn_exp2f(fmaf(p1[r], C2, mnc)); ps += p0[r] + p1[r]; }
        ps += __shfl_xor(ps, 32);
        l = l * alpha + ps; m = mn;
        if (__any(alpha < 1.f)) { if (hi == 0) al_l[r32] = alpha; LDS_WAIT();
#pragma unroll
            for (int r = 0; r < 16; ++r) { const float a = al_l[crow(r, hi)];
#pragma unroll
                for (int d0 = 0; d0 < 4; ++d0) o[d0][r] *= a; }
            LDS_WAIT(); }
        tile_v_finish(wl, lane, pend);
        bf16x8 pa0, pa1, pa2, pa3; pack_p(p0, p1, pa0, pa1, pa2, pa3);
        pv_one<0>(o[0], vb, pa0, pa1, pa2, pa3); pv_one<1>(o[1], vb, pa0, pa1, pa2, pa3); pv_one<2>(o[2], vb, pa0, pa1, pa2, pa3); pv_one<3>(o[3], vb, pa0, pa1, pa2, pa3);
    }
    if (hi == 0) { al_l[r32] = l; *(f32x2*)(ST + ((size_t)(iq * d + rr) * NDLH + h) * 2) = (f32x2){m * ATT_SCALE, l}; }
    LDS_WAIT();
    { LAS unsigned char* const odst = wl + (4 * hi) * 272 + r32 * 2;
#pragma unroll
      for (int r = 0; r < 16; ++r) { const float rl = 1.0f / al_l[crow(r, hi)];
#pragma unroll
        for (int d0 = 0; d0 < 4; ++d0) *(LAS bf16*)(odst + ((r & 3) + 8 * (r >> 2)) * 272 + d0 * 64) = (bf16)(pk2(o[d0][r] * rl, 0.f) & 0xffffu); } }
    strip_o_store(OB, i0 * d + rr, d, DLW, h * HD, wl, lane);
    LDS_WAIT();
}
__device__ __forceinline__ void seg_norm_dl(const bf16* OB, const float* ST, int t, const float* gain, bf16* dst, int lane_) {
    int lane = lane_; asm volatile("" : "+v"(lane));
    float v[3][8]; float ss = 0.f;
#pragma unroll
    for (int i = 0; i < 3; ++i) { const int hd = 4 * i + (lane >> 4);
        f32x2 st[3]; float mx = -1e30f;
#pragma unroll
        for (int b = 0; b < 3; ++b) { st[b] = *(const f32x2*)(ST + (((size_t)b * SEQ + t) * NDLH + hd) * 2); mx = fmaxf(mx, st[b].x); }
        float w[3], den = 0.f;
#pragma unroll
        for (int b = 0; b < 3; ++b) { w[b] = __expf(st[b].x - mx) * st[b].y; den += w[b]; }
        const float rden = 1.0f / den;
#pragma unroll
        for (int e = 0; e < 8; ++e) v[i][e] = 0.f;
#pragma unroll
        for (int b = 0; b < 3; ++b) { const v4u a = *(const v4u*)(OB + ((size_t)b * SEQ + t) * DLW + 8 * lane + 512 * i); const float wb = w[b] * rden;
            v[i][0] += wb * bflo(a.x); v[i][1] += wb * bfhi(a.x); v[i][2] += wb * bflo(a.y); v[i][3] += wb * bfhi(a.y);
            v[i][4] += wb * bflo(a.z); v[i][5] += wb * bfhi(a.z); v[i][6] += wb * bflo(a.w); v[i][7] += wb * bfhi(a.w); }
#pragma unroll
        for (int e = 0; e < 8; ++e) ss += v[i][e] * v[i][e];
    }
    const float r = 1.0f / sqrtf(wave_sum(ss) * (1.0f / DLW) + RMS_EPS);
#pragma unroll
    for (int i = 0; i < 3; ++i) { const f32x4 g0 = *(const f32x4*)(gain + 8 * lane + 512 * i), g1 = *(const f32x4*)(gain + 8 * lane + 512 * i + 4);
        v4u o; o.x = pk2(v[i][0] * r * g0.x, v[i][1] * r * g0.y); o.y = pk2(v[i][2] * r * g0.z, v[i][3] * r * g0.w);
        o.z = pk2(v[i][4] * r * g1.x, v[i][5] * r * g1.y); o.w = pk2(v[i][6] * r * g1.z, v[i][7] * r * g1.w);
        *(v4u*)(dst + 8 * lane + 512 * i) = o; }
}


__device__ __forceinline__ void gains3_to_lds(const float* g_sb, const float* g_dl, const float* g_ssm, LAS float* gl, int lane_, int wid) {
    int lane = lane_; asm volatile("" : "+v"(lane));
    __syncthreads();
#pragma unroll
    for (int q = 0; q < 2; ++q) { const int i = (q * NWAVES + wid) * 64 + lane;
        const f32x4 v = i < 384 ? ((const f32x4*)g_sb)[i] : (i < 768 ? ((const f32x4*)g_dl)[i - 384] : ((const f32x4*)g_ssm)[i - 768]);
        ((LAS f32x4*)gl)[i] = v; }
    LDS_WAIT();
    __syncthreads();
}
__device__ __forceinline__ float ssq8(const v4u& a) {
    return (bflo(a.x) * bflo(a.x) + bfhi(a.x) * bfhi(a.x)) + (bflo(a.y) * bflo(a.y) + bfhi(a.y) * bfhi(a.y)) + (bflo(a.z) * bflo(a.z) + bfhi(a.z) * bfhi(a.z)) + (bflo(a.w) * bflo(a.w) + bfhi(a.w) * bfhi(a.w));
}
__device__ __forceinline__ v4u scale8(const v4u& a, float r, const f32x4& g0, const f32x4& g1) {
    v4u o; o.x = pk2(bflo(a.x) * r * g0.x, bfhi(a.x) * r * g0.y); o.y = pk2(bflo(a.y) * r * g0.z, bfhi(a.y) * r * g0.w);
    o.z = pk2(bflo(a.z) * r * g1.x, bfhi(a.z) * r * g1.y); o.w = pk2(bflo(a.w) * r * g1.z, bfhi(a.w) * r * g1.w); return o;
}
template <bool AB, bool SSM>
__device__ __forceinline__ void mix_row(const bf16* OSBp, const bf16* ODLp, const float* ST, const bf16* OSSMp, int t, const LAS float* gl, bf16* MIXp, int lane_) {
    int lane = lane_; asm volatile("" : "+v"(lane));
    v4u a_sb[3], a_dl[3][3], a_ss[2]; f32x2 st[3][3];
    if (AB) {
#pragma unroll
        for (int i = 0; i < 3; ++i) a_sb[i] = *(const v4u*)(OSBp + (size_t)t * SBW + 8 * lane + 512 * i);
#pragma unroll
        for (int i = 0; i < 3; ++i) { const int hd = 4 * i + (lane >> 4);
#pragma unroll
            for (int b = 0; b < 3; ++b) { st[i][b] = *(const f32x2*)(ST + (((size_t)b * SEQ + t) * NDLH + hd) * 2); a_dl[i][b] = *(const v4u*)(ODLp + ((size_t)b * SEQ + t) * DLW + 8 * lane + 512 * i); } }
    }
    if (SSM) {
#pragma unroll
        for (int i = 0; i < 2; ++i) a_ss[i] = *(const v4u*)(OSSMp + (size_t)t * SSMC + 8 * lane + 512 * i);
    }
    asm volatile("" ::: "memory");
    bf16* dst = MIXp + (size_t)t * DM;
    if (AB) {
        {
            float ss = 0.f;
#pragma unroll
            for (int i = 0; i < 3; ++i) ss += ssq8(a_sb[i]);
            const float r = 1.0f / sqrtf(wave_sum(ss) * (1.0f / SBW) + RMS_EPS);
#pragma unroll
            for (int i = 0; i < 3; ++i) { const f32x4 g0 = *(const LAS f32x4*)(gl + 8 * lane + 512 * i), g1 = *(const LAS f32x4*)(gl + 8 * lane + 512 * i + 4);
                *(v4u*)(dst + 8 * lane + 512 * i) = scale8(a_sb[i], r, g0, g1); }
        }
        {
            float v[3][8]; float ss = 0.f;
#pragma unroll
            for (int i = 0; i < 3; ++i) {
                float mx = -1e30f;
#pragma unroll
                for (int b = 0; b < 3; ++b) mx = fmaxf(mx, st[i][b].x);
                float w[3], den = 0.f;
#pragma unroll
                for (int b = 0; b < 3; ++b) { w[b] = __expf(st[i][b].x - mx) * st[i][b].y; den += w[b]; }
                const float rden = 1.0f / den;
#pragma unroll
                for (int e = 0; e < 8; ++e) v[i][e] = 0.f;
#pragma unroll
                for (int b = 0; b < 3; ++b) { const v4u a = a_dl[i][b]; const float wb = w[b] * rden;
                    v[i][0] += wb * bflo(a.x); v[i][1] += wb * bfhi(a.x); v[i][2] += wb * bflo(a.y); v[i][3] += wb * bfhi(a.y);
                    v[i][4] += wb * bflo(a.z); v[i][5] += wb * bfhi(a.z); v[i][6] += wb * bflo(a.w); v[i][7] += wb * bfhi(a.w); }
#pragma unroll
                for (int e = 0; e < 8; ++e) ss += v[i][e] * v[i][e];
            }
            const float r = 1.0f / sqrtf(wave_sum(ss) * (1.0f / DLW) + RMS_EPS);
#pragma unroll
            for (int i = 0; i < 3; ++i) { const f32x4 g0 = *(const LAS f32x4*)(gl + SBW + 8 * lane + 512 * i), g1 = *(const LAS f32x4*)(gl + SBW + 8 * lane + 512 * i + 4);
                v4u o; o.x = pk2(v[i][0] * r * g0.x, v[i][1] * r * g0.y); o.y = pk2(v[i][2] * r * g0.z, v[i][3] * r * g0.w);
                o.z = pk2(v[i][4] * r * g1.x, v[i][5] * r * g1.y); o.w = pk2(v[i][6] * r * g1.z, v[i][7] * r * g1.w);
                *(v4u*)(dst + SBW + 8 * lane + 512 * i) = o; }
        }
    }
    if (SSM) {
        float ss = 0.f;
#pragma unroll
        for (int i = 0; i < 2; ++i) ss += ssq8(a_ss[i]);
        const float r = 1.0f / sqrtf(wave_sum(ss) * (1.0f / SSMC) + RMS_EPS);
#pragma unroll
        for (int i = 0; i < 2; ++i) { const f32x4 g0 = *(const LAS f32x4*)(gl + SBW + DLW + 8 * lane + 512 * i), g1 = *(const LAS f32x4*)(gl + SBW + DLW + 8 * lane + 512 * i + 4);
            *(v4u*)(dst + SBW + DLW + 8 * lane + 512 * i) = scale8(a_ss[i], r, g0, g1); }
    }
}

struct Args { const float* in[23]; float* out; unsigned char* ws; int s_lo, s_hi; };

constexpr int I_IN = 64 * 160, I_GLU = 16 * 16, I_OUT = 64 * 64, I_G = 64 * 172, I_D = 172 * 64, I_L = I_IN + I_GLU + I_OUT + 2 * I_G + I_D;
__device__ __forceinline__ ConvItem conv_decode(const Args& args, unsigned char* ws, int item) {
    const int l = item / I_L; int r = item % I_L; ConvItem c;
    unsigned char* const WL = ws + WS_W + (size_t)l * WL_BYTES;
    if (r < I_IN) { c.W = args.in[5] + (size_t)l * DM * INW; c.K = DM; c.N = INW; c.WT = (bf16*)(WL + WO_IN); c.k0 = 64 * (r / 160); c.n0 = 64 * (r % 160); c.orow0 = c.n0; return c; } r -= I_IN;
    if (r < I_GLU) { c.W = args.in[17] + (size_t)l * SSMC * SSMC; c.K = SSMC; c.N = SSMC; c.WT = (bf16*)(WL + WO_GLU); c.k0 = 64 * (r / 16); c.n0 = 64 * (r % 16); c.orow0 = c.n0; return c; } r -= I_GLU;
    if (r < I_OUT) { c.W = args.in[19] + (size_t)l * DM * DM; c.K = DM; c.N = DM; c.WT = (bf16*)(WL + WO_OUT); c.k0 = 64 * (r / 64); c.n0 = 64 * (r % 64); c.orow0 = c.n0; return c; } r -= I_OUT;
    if (r < 2 * I_G) { const int up = r >= I_G; if (up) r -= I_G; c.W = args.in[up ? 21 : 20] + (size_t)l * DM * FFN; c.K = DM; c.N = FFN; c.WT = (bf16*)(WL + WO_GU); c.k0 = 64 * (r / 172); c.n0 = 64 * (r % 172);
        c.orow0 = 256 * (c.n0 / 128) + (c.n0 % 128) + (up ? 128 : 0); return c; } r -= 2 * I_G;
    c.W = args.in[22] + (size_t)l * FFN * DM; c.K = FFN; c.N = DM; c.WT = (bf16*)(WL + WO_DN); c.k0 = 64 * (r / 64); c.n0 = 64 * (r % 64); c.orow0 = c.n0; return c;
}
__device__ __forceinline__ void conv_item(const Args& args, unsigned char* ws, int l, int r, LAS float* scr, int lane) {
    bf16* const WL = (bf16*)(ws + WS_W + (size_t)l * WL_BYTES);
    if (r < I_IN) { tr_tile(args.in[5] + (size_t)l * DM * INW, DM, INW, (bf16*)((unsigned char*)WL + WO_IN), 64 * (r / 160), 64 * (r % 160), 64 * (r % 160), scr, lane); return; } r -= I_IN;
    if (r < I_GLU) { tr_tile(args.in[17] + (size_t)l * SSMC * SSMC, SSMC, SSMC, (bf16*)((unsigned char*)WL + WO_GLU), 64 * (r / 16), 64 * (r % 16), 64 * (r % 16), scr, lane); return; } r -= I_GLU;
    if (r < I_OUT) { tr_tile(args.in[19] + (size_t)l * DM * DM, DM, DM, (bf16*)((unsigned char*)WL + WO_OUT), 64 * (r / 64), 64 * (r % 64), 64 * (r % 64), scr, lane); return; } r -= I_OUT;
    if (r < 2 * I_G) { const int up = r >= I_G; if (up) r -= I_G; const int n0 = 64 * (r % 172);
        tr_tile(args.in[up ? 21 : 20] + (size_t)l * DM * FFN, DM, FFN, (bf16*)((unsigned char*)WL + WO_GU), 64 * (r / 172), n0, 256 * (n0 / 128) + (n0 % 128) + (up ? 128 : 0), scr, lane); return; } r -= 2 * I_G;
    tr_tile(args.in[22] + (size_t)l * FFN * DM, FFN, DM, (bf16*)((unsigned char*)WL + WO_DN), 64 * (r / 64), 64 * (r % 64), 64 * (r % 64), scr, lane);
}
__global__ void __launch_bounds__(NWAVES * 64, 2) hybrid_fwd(Args args) {
    extern __shared__ __attribute__((aligned(16))) unsigned char lds_raw[];
    LAS unsigned char* const lds = (LAS unsigned char*)lds_raw;
    volatile LAS unsigned* const MISC = (volatile LAS unsigned*)(lds + MISC_OFF);
    const int wave = __builtin_amdgcn_readfirstlane((int)threadIdx.x >> 6);
    const int G = gridDim.x, gw = blockIdx.x * NWAVES + wave, ngw = G * NWAVES;
    unsigned char* const ws = args.ws;
    gu32* const ctl = (gu32*)(ws + WS_CTL);
    LAS unsigned char* const wl = lds + wave * WAVE_LDS;
    for (int u = threadIdx.x; u < (LDS_BYTES - LDSCTL_OFF) / 4; u += NWAVES * 64) ((LAS unsigned*)(lds + LDSCTL_OFF))[u] = 0u;
    __syncthreads();
    const int s_lo = args.s_lo, s_hi = args.s_hi;
    XcdBarrier bar; bar.bar = (unsigned*)(ctl + CW_BAR); bar.x = 0; bar.st = nullptr; bar.w = wave;
    if (s_hi - s_lo > 1) bar = xcd_barrier_post((unsigned*)(ctl + CW_BAR), MISC + 8, wave);
#ifndef ROW_PF6
#define ROW_PF6 true
#endif
#ifndef ROW_PF9A
#define ROW_PF9A true
#endif
#ifndef ROW_PF9B
#define ROW_PF9B false
#endif
#ifndef ROW_PF0
#define ROW_PF0 false
#endif
#ifndef RES_F32
#define RES_F32 0
#endif
#ifndef STEP_MASK
#define STEP_MASK 0x7ff
#endif
#define EN(k) (((STEP_MASK) >> (k)) & 1)
#ifndef REP_MASK
#define REP_MASK 0
#endif
#define NREP(k) ((((REP_MASK) >> (k)) & 1) ? 2 : 1)
#ifndef MIX_NAIVE
#define MIX_NAIVE 0
#endif
#ifndef PROBE_P0
#define PROBE_P0 1
#endif
#ifndef PROBE_GU
#define PROBE_GU 0
#endif
#ifndef PROBE_S2
#define PROBE_S2 1
#endif
#ifndef PROBE_TD
#define PROBE_TD 1
#endif
#ifndef PROBE_TF
#define PROBE_TF 1
#endif
#ifndef EXP_DELAY
#define EXP_DELAY 0
#endif
#ifndef CONV_DEFER
#define CONV_DEFER 0
#endif
#ifndef CONV_PER_UNIT
#define CONV_PER_UNIT 6
#endif
#ifndef PROBE_GEMM
#define PROBE_GEMM 0
#endif
#ifndef TD_EARLY
#define TD_EARLY 5120
#endif
#ifndef CONV_PIPE
#define CONV_PIPE 1
#endif
#ifndef CONV_REVERSE
#define CONV_REVERSE 1
#endif
#ifndef MIX_STAGGER
#define MIX_STAGGER 0
#endif
#ifndef MIX_ITEMS
#define MIX_ITEMS 0
#endif
#ifndef TAIL_ITEMS
#define TAIL_ITEMS 0
#endif
#ifndef PROBE_SB
#define PROBE_SB 1
#endif
#ifndef PROBE_DL
#define PROBE_DL 1
#endif
#ifndef PROBE_S1
#define PROBE_S1 1
#endif
#define RUN(s) (s_lo <= (s) && (s) < s_hi)
#ifndef PROBE_BAR
#define PROBE_BAR 1
#endif
#define SEAM(s) do { if (RUN(s) && RUN((s) + 1)) { xcd_barrier(bar); if (PROBE_BAR > 1) xcd_barrier(bar); } } while (0)

    const float* const x_in = args.in[0];
    bf16* const XN = (bf16*)(ws + WS_XN); bf16* const PROJ = (bf16*)(ws + WS_PROJ); bf16* const OSB = (bf16*)(ws + WS_OSB); bf16* const HB = (bf16*)(ws + WS_H);
    bf16* const MIX = (bf16*)(ws + WS_MIX); bf16* const FB = (bf16*)(ws + WS_F);
#if RES_F32
    typedef float res_t; res_t* const X1 = (res_t*)(ws + WS_X1); res_t* const XL = args.out;
#else
    typedef bf16 res_t; res_t* const X1 = (res_t*)(ws + WS_X1); res_t* const XL = (res_t*)(ws + WS_X1 + 64 * MiB);
#endif
    bf16* const ODL = (bf16*)(ws + WS_ODL);
    bf16* const GB = (bf16*)(ws + WS_G); bf16* const OSSM = (bf16*)(ws + WS_OSSM); float* const XE = (float*)(ws + WS_XE); float* const STAT = (float*)(ws + WS_STAT);

    if (EN(0) && RUN(0)) { const int ln = fresh_lane();
        LAS float* scr = (LAS float*)wl;
        const int ntail = (G == 256) ? TAIL_ITEMS + MIX_ITEMS : 0;
        const int nconv = DEPTH * I_L - ntail;
#define CONV_MAP(i) (CONV_REVERSE && ntail == 0 ? nconv - 1 - (i) : ((i) < I_L ? (i) : (i) + ntail))
#if CONV_PIPE
        {
            f32x4 va[16], vb[16]; int it0 = gw; const int nit = PROBE_P0 * nconv;
            ConvItem ca = conv_decode(args, ws, CONV_MAP((it0 < nit ? it0 : 0) % nconv)), cb = ca;
            if (it0 < nit) tr_load(ca, ln, va);
            while (it0 < nit) {
                const int it1 = it0 + ngw; if (it1 < nit) { cb = conv_decode(args, ws, CONV_MAP(it1 % nconv)); tr_load(cb, ln, vb); }
                tr_store(ca, scr, ln, va);
                if (it1 >= nit) break;
                const int it2 = it1 + ngw; if (it2 < nit) { ca = conv_decode(args, ws, CONV_MAP(it2 % nconv)); tr_load(ca, ln, va); }
                tr_store(cb, scr, ln, vb);
                it0 = it2;
            }
        }
#else
        for (int it0 = gw; it0 < PROBE_P0 * nconv; it0 += ngw) { const int it = CONV_MAP(it0 % nconv); conv_item(args, ws, it / I_L, it % I_L, scr, ln); }
#endif
#undef CONV_MAP
        for (int m0 = gw; m0 < PROBE_P0 * SEQ; m0 += ngw) { const int m = m0 % SEQ; row_op(x_in + (size_t)m * DM, (const bf16*)nullptr, (const float*)nullptr, (float*)nullptr, args.in[1], XN + (size_t)m * DM, ln); }
    }
    SEAM(0);

    for (int l = 0; l < DEPTH; ++l) {
        const int sb = 1 + STEPS_PER_LAYER * l;
        const unsigned char* const WL = ws + WS_W + (size_t)l * WL_BYTES;
        if (EN(1) && RUN(sb + 0)) {
            pg8::Gemm g{XN, (const bf16*)(WL + WO_IN), SEQ, INW, DM}; pg8::StaticOrder S; S.init(SEQ, INW, G, (int)blockIdx.x);
            pg8::EpiStoreBf16 E{PROJ, INW};
            pg8::gemm_phase<pg8::EpiStoreBf16, pg8::StaticOrder, true, true>(lds, g, S, E, wave);
#if PROBE_GEMM == 1 || PROBE_GEMM == 9
            pg8::gemm_phase<pg8::EpiStoreBf16, pg8::StaticOrder, true, true>(lds, g, S, E, wave);
#endif
        }
        SEAM(sb + 0);
        if (EN(2) && RUN(sb + 1)) { const int ln = fresh_lane();
            const int gwx = (G % 8 == 0) ? (((int)blockIdx.x % 8) * (G / 8) + (int)blockIdx.x / 8) * NWAVES + wave : gw;
            int tc = gw;
#define CONV_SOME(n) do { if (MIX_ITEMS > 0 && G == 256 && l == 0) for (int q_ = 0; q_ < (n) && tc < MIX_ITEMS; ++q_, tc += ngw) conv_item(args, ws, 1, TAIL_ITEMS + tc, (LAS float*)wl, ln); } while (0)
#if EXP_OLDSSM & 1
            SsmWOld wo{args.in[9] + l * NGRP * NST, args.in[10] + l * NGRP * NST, args.in[11] + l * NGRP, args.in[12] + (size_t)l * NGRP * NST * SGRP, args.in[13] + (size_t)l * NGRP * NST * SGRP,
                   args.in[14] + (size_t)l * NGRP * SGRP * NST, args.in[15] + (size_t)l * NGRP * SGRP * NST, args.in[16] + l * SSMC};
            for (int u = gw; u < SSM_NCH * NGRP; u += ngw) ssm_pass1_old(PROJ, wo, XE, u % NGRP, u / NGRP, wl, ln);
#else
            const SsmW w{args.in[9] + l * NGRP * NST, args.in[10] + l * NGRP * NST, args.in[11] + l * NGRP, args.in[12] + (size_t)l * NGRP * NST * SGRP, args.in[13] + (size_t)l * NGRP * NST * SGRP,
                         args.in[14] + (size_t)l * NGRP * SGRP * NST, args.in[15] + (size_t)l * NGRP * SGRP * NST, args.in[16] + l * SSMC};
#if MIX_STAGGER
#pragma clang loop unroll(disable)
            for (int ph = 0; ph < 2; ++ph) {
            if ((ph == 0) == (((wave >> 2) & 1) == 1))
#endif
            for (int u = gwx; u < PROBE_S1 * SSM_NCH * NGRP; u += ngw) { const int v = u % (SSM_NCH * NGRP); ssm_unit<false>(PROJ, w, XE, nullptr, v % NGRP, v / NGRP, wl, ln); }
#if MIX_STAGGER
            else {
#endif
#endif
#if MIX_NAIVE
            for (int u = gw; u < PROBE_SB * NSBH * SEQ; u += ngw) { const int v = u % (NSBH * SEQ); sb_naive(PROJ, OSB, v / SEQ, v % SEQ, ln); }
            for (int u = gw; u < PROBE_DL * NDLH * SEQ; u += ngw) { const int v = u % (NDLH * SEQ); dl_naive(PROJ, ODL, v / SEQ, v % SEQ, ln); }
#else
            for (int u = gwx; u < PROBE_SB * NSBH * 256; u += ngw) { const int v = u % (NSBH * 256); sb_strip(PROJ, OSB, v >> 8, 32 * (v & 255), wl, ln); }
            for (int u = ngw - 1 - gwx; u < PROBE_DL * 3 * NDLH * 256; u += ngw) { const int v = u % (3 * NDLH * 256),
                b = v / (NDLH * 256), rem = v % (NDLH * 256), hh = rem >> 8, sidx = rem & 255;
                const int d = b == 0 ? 1 : (b == 1 ? 4 : 16), spr = 256 / d;
                dl_strip(PROJ, ODL + (size_t)b * SEQ * DLW, STAT + (size_t)b * SEQ * NDLH * 2, hh, d, sidx / spr, 32 * (sidx % spr), wl, ln); CONV_SOME(CONV_PER_UNIT); }
#endif
#if MIX_STAGGER && !(EXP_OLDSSM & 1)
            } }
#endif
#undef CONV_SOME
        }
        SEAM(sb + 1);
        if (EN(3) && RUN(sb + 2)) { const int ln = fresh_lane();
            const int gwx = (G % 8 == 0) ? (((int)blockIdx.x % 8) * (G / 8) + (int)blockIdx.x / 8) * NWAVES + wave : gw;
#if EXP_DELAY
            for (int i = 0; i < 40; ++i) __builtin_amdgcn_s_sleep(127);
#endif
#if EXP_OLDSSM & 2
            SsmWOld wo{args.in[9] + l * NGRP * NST, args.in[10] + l * NGRP * NST, args.in[11] + l * NGRP, args.in[12] + (size_t)l * NGRP * NST * SGRP, args.in[13] + (size_t)l * NGRP * NST * SGRP,
                   args.in[14] + (size_t)l * NGRP * SGRP * NST, args.in[15] + (size_t)l * NGRP * SGRP * NST, args.in[16] + l * SSMC};
            for (int u = gw; u < SSM_NCH * NGRP; u += ngw) ssm_pass2_old(PROJ, wo, XE, GB, u % NGRP, u / NGRP, wl, ln);
#else
            const SsmW w{args.in[9] + l * NGRP * NST, args.in[10] + l * NGRP * NST, args.in[11] + l * NGRP, args.in[12] + (size_t)l * NGRP * NST * SGRP, args.in[13] + (size_t)l * NGRP * NST * SGRP,
                         args.in[14] + (size_t)l * NGRP * SGRP * NST, args.in[15] + (size_t)l * NGRP * SGRP * NST, args.in[16] + l * SSMC};
            for (int u = gwx; u < PROBE_S2 * SSM_NCH * NGRP; u += ngw) { const int v = u % (SSM_NCH * NGRP), c = v / NGRP;
                ssm_unit<true>(PROJ, w, XE, GB, v % NGRP, c < SSM_NCH / 2 ? c : 3 * SSM_NCH / 2 - 1 - c, wl, ln); }
#endif
        }
        SEAM(sb + 2);
        if (EN(4) && RUN(sb + 3)) {
#if EXP_DELAY
            for (int i = 0; i < 40; ++i) __builtin_amdgcn_s_sleep(127);
#endif
            pg8::Gemm g{GB, (const bf16*)(WL + WO_GLU), SEQ, SSMC, SSMC}; pg8::StaticOrder S; S.init(SEQ, SSMC, G, (int)blockIdx.x);
            pg8::EpiGlu E{GB, OSSM, SSMC, args.in[18] + l * SSMC};
            pg8::gemm_phase<pg8::EpiGlu, pg8::StaticOrder, true, true>(lds, g, S, E, wave);
            const int nun = (SEQ / 256) * (SSMC / 256);
            if ((int)blockIdx.x >= nun && G > nun) { const int ln = fresh_lane(); const int gw2 = ((int)blockIdx.x - nun) * NWAVES + wave, ngw2 = (G - nun) * NWAVES;
                gains3_to_lds(args.in[6] + l * SBW, args.in[7] + l * DLW, args.in[8] + l * SSMC, (LAS float*)lds, ln, wave);
                for (int t = gw2; t < TD_EARLY; t += ngw2) mix_row<true, false>(OSB, ODL, STAT, OSSM, t, (const LAS float*)lds, MIX, ln); }
        }
        SEAM(sb + 3);
        if (EN(5) && RUN(sb + 4)) { const int ln = fresh_lane();
            const int t_early = (G > (SEQ / 256) * (SSMC / 256)) ? TD_EARLY : 0;
            gains3_to_lds(args.in[6] + l * SBW, args.in[7] + l * DLW, args.in[8] + l * SSMC, (LAS float*)lds, ln, wave);
            for (int t0 = gw; t0 < PROBE_TD * SEQ; t0 += ngw) { const int t = t0 % SEQ;
                if (t >= t_early) mix_row<true, true>(OSB, ODL, STAT, OSSM, t, (const LAS float*)lds, MIX, ln);
                else mix_row<false, true>(OSB, ODL, STAT, OSSM, t, (const LAS float*)lds, MIX, ln);
            }
        }
        SEAM(sb + 4);
        if (EN(6) && RUN(sb + 5)) {
            pg8::Gemm g{MIX, (const bf16*)(WL + WO_OUT), SEQ, DM, DM}; pg8::StaticOrder S; S.init(SEQ, DM, G, (int)blockIdx.x);
            pg8::EpiStoreBf16 E{FB, DM};
            pg8::gemm_phase<pg8::EpiStoreBf16, pg8::StaticOrder, true, true>(lds, g, S, E, wave);
#if PROBE_GEMM == 2 || PROBE_GEMM == 9
            pg8::gemm_phase<pg8::EpiStoreBf16, pg8::StaticOrder, true, true>(lds, g, S, E, wave);
#endif
        }
        SEAM(sb + 5);
        if (EN(7) && RUN(sb + 6)) { const int ln = fresh_lane();
            gains_to_lds(args.in[2] + l * DM, args.in[3] + l * DM, (LAS float*)lds, ln, wave);
            if (l == 0) row_phase<float, res_t, true, ROW_PF0>(x_in, FB, (const LAS float*)lds, X1, XN, gw, ngw, PROBE_TF * SEQ, ln);
            else row_phase<res_t, res_t, true, ROW_PF6>(XL, FB, (const LAS float*)lds, X1, XN, gw, ngw, PROBE_TF * SEQ, ln);
        }
        SEAM(sb + 6);
        if (EN(8) && RUN(sb + 7)) {
            pg8::Gemm g{XN, (const bf16*)(WL + WO_GU), SEQ, GUW, DM}; pg8::StaticOrder S; S.init(SEQ, GUW, G, (int)blockIdx.x);
            pg8::EpiSwiGLU E{HB, FFN};
            pg8::gemm_phase<pg8::EpiSwiGLU, pg8::StaticOrder, true, true>(lds, g, S, E, wave);
            if (l == 0 && G == 256 && (int)blockIdx.x >= 192) { const int ln = fresh_lane(); const int gw2 = ((int)blockIdx.x - 192) * NWAVES + wave;
                for (int it = gw2; it < TAIL_ITEMS; it += 64 * NWAVES) conv_item(args, ws, 1, it, (LAS float*)wl, ln); }
#if PROBE_GU || PROBE_GEMM == 9
            pg8::gemm_phase<pg8::EpiSwiGLU, pg8::StaticOrder, true, true>(lds, g, S, E, wave);
#endif
        }
        SEAM(sb + 7);
        if (EN(9) && RUN(sb + 8)) {
            pg8::Gemm g{HB, (const bf16*)(WL + WO_DN), SEQ, DM, FFN}; pg8::StaticOrder S; S.init(SEQ, DM, G, (int)blockIdx.x);
            pg8::EpiStoreBf16 E{FB, DM};
            pg8::gemm_phase<pg8::EpiStoreBf16, pg8::StaticOrder, true, true>(lds, g, S, E, wave);
#if PROBE_GEMM == 3 || PROBE_GEMM == 9
            pg8::gemm_phase<pg8::EpiStoreBf16, pg8::StaticOrder, true, true>(lds, g, S, E, wave);
#endif
        }
        SEAM(sb + 8);
        if (EN(10) && RUN(sb + 9)) { const int ln = fresh_lane();
            const bool more = l + 1 < DEPTH;
            gains_to_lds(args.in[4] + l * DM, more ? args.in[1] + (l + 1) * DM : nullptr, (LAS float*)lds, ln, wave);
            if (more) row_phase<res_t, res_t, true, ROW_PF9A>(X1, FB, (const LAS float*)lds, XL, XN, gw, ngw, PROBE_TF * SEQ, ln);
            else row_phase<res_t, float, false, ROW_PF9B>(X1, FB, (const LAS float*)lds, args.out, (bf16*)nullptr, gw, ngw, PROBE_TF * SEQ, ln);
        }
        SEAM(sb + 9);
    }
#undef RUN
#undef SEAM
}

extern "C" void kernel_launch(void* const* d_in, const int* in_sizes, int n_in, void* d_out, int out_size, void* d_ws, size_t ws_size, hipStream_t stream) {
    static int grid = 0;
    if (grid == 0) {
        if (n_in != 23 || in_sizes[0] != SEQ * DM || out_size != SEQ * DM || ws_size < WS_END) { fprintf(stderr, "kernel_launch: unexpected shapes (n_in %d, in0 %d, out %d, ws %zu < %zu); nothing launched\n", n_in, n_in > 0 ? in_sizes[0] : -1, out_size, ws_size, (size_t)WS_END); grid = -1; return; }
        int dev = 0, cus = 0, per_cu = 0;
        if (hipGetDevice(&dev) != hipSuccess || hipDeviceGetAttribute(&cus, hipDeviceAttributeMultiprocessorCount, dev) != hipSuccess) { fprintf(stderr, "kernel_launch: device query failed\n"); grid = -1; return; }
        if (hipFuncSetAttribute((const void*)hybrid_fwd, hipFuncAttributeMaxDynamicSharedMemorySize, LDS_BYTES) != hipSuccess) { fprintf(stderr, "kernel_launch: hipFuncSetAttribute failed\n"); grid = -1; return; }
        if (hipOccupancyMaxActiveBlocksPerMultiprocessor(&per_cu, (const void*)hybrid_fwd, NWAVES * 64, LDS_BYTES) != hipSuccess || per_cu < 1)
            fprintf(stderr, "kernel_launch: note: occupancy query reports %d workgroups per CU\n", per_cu);
        (void)hipGetLastError();
        grid = cus;
    }
    if (grid < 0) return;
    if (hipMemsetAsync((char*)d_ws + WS_CTL, 0, CTL_ZERO_BYTES, stream) != hipSuccess) { fprintf(stderr, "kernel_launch: hipMemsetAsync failed\n"); return; }
    Args a{};
    for (int i = 0; i < 23; ++i) a.in[i] = (const float*)d_in[i];
    a.out = (float*)d_out; a.ws = (unsigned char*)d_ws;
#if MK_SINGLE
    a.s_lo = 0; a.s_hi = NSTEPS;
    hipLaunchKernelGGL(hybrid_fwd, dim3(grid), dim3(NWAVES * 64), LDS_BYTES, stream, a);
#else
    for (int s = 0; s < NSTEPS; ++s) { a.s_lo = s; a.s_hi = s + 1; hipLaunchKernelGGL(hybrid_fwd, dim3(grid), dim3(NWAVES * 64), LDS_BYTES, stream, a); }
#endif
    const hipError_t le = hipPeekAtLastError();
    if (le != hipSuccess) fprintf(stderr, "kernel_launch: launch failed: %s\n", hipGetErrorName(le));
}
```

```cpp
#include <hip/hip_runtime.h>
#include <cstdio>
#include <cstdint>
namespace pg8 {
#define PG8_LAS __attribute__((address_space(3)))
typedef unsigned short bf16_t;
typedef short bf16x8 __attribute__((ext_vector_type(8)));
typedef float f32x4 __attribute__((ext_vector_type(4)));
typedef unsigned u32x4 __attribute__((ext_vector_type(4)));
constexpr int BM = 256, BK = 64, HALF = 128, HTB = HALF * BK * 2  , STAGE_BYTES = 8 * HTB, NXCD = 8, WGM = 8;

__host__ __device__ __forceinline__ int lds_byte(int r, int c) { const int st = (r >> 4) * 2 + (c >> 5), rr = r & 15, cc = c & 31, ob = rr * 64 + cc * 2; return st * 1024 + (ob ^ (((ob >> 9) & 1) << 5)); }
__host__ __device__ __forceinline__ void stage_rc(int b, int& R, int& C) { const int st = b / 1024, sb = b % 1024, swz = sb ^ (((sb >> 9) & 1) << 5); R = (st >> 1) * 16 + swz / 64; C = (st & 1) * 32 + (swz % 64) / 2; }
__host__ __device__ __forceinline__ int perm32(int rho) { const int n = rho >> 4, i = rho & 15; return 8 * (i >> 2) + 4 * n + (i & 3); }

struct Unit { int pm, pn; };
struct Gemm { const bf16_t* A; const bf16_t* Bt; int M, N, K; };

struct StaticOrder {
    int nM, nN, nwg, G, c;
    __host__ __device__ void init(int M, int N, int G_, int c_) { nM = M / BM; nN = N / BM; nwg = nM * nN; G = G_; c = c_; }
    __host__ __device__ bool next(int i, Unit& u) const {
        const long L = (long)i * G + c; if (L >= nwg) return false;
        int wgid = (int)L; { const int q = nwg / NXCD, r = nwg % NXCD, xcd = wgid % NXCD, off = wgid / NXCD; wgid = (xcd < r ? xcd * (q + 1) : r * (q + 1) + (xcd - r) * q) + off; }
        const int nig = WGM * nN, gid = wgid / nig, fm = gid * WGM, gsz = (nM - fm) < WGM ? (nM - fm) : WGM;
        u.pm = fm + ((wgid % nig) % gsz); u.pn = (wgid % nig) / gsz; return true;
    }
    __device__ __forceinline__ void a_ready(const Unit&) const {}
    __device__ __forceinline__ void done(const Unit&) const {}
};


__device__ __forceinline__ unsigned cvt_pk_bf16(float lo, float hi) { unsigned r; asm volatile("v_cvt_pk_bf16_f32 %0, %1, %2" : "=v"(r) : "v"(lo), "v"(hi)); return r; }
__device__ __forceinline__ float bf_lo(unsigned w) { return __uint_as_float(w << 16); }
__device__ __forceinline__ float bf_hi(unsigned w) { return __uint_as_float(w & 0xffff0000u); }
__device__ __forceinline__ float fast_sigmoid(float x) { return __builtin_amdgcn_rcpf(1.0f + __builtin_amdgcn_exp2f(-1.4426950408889634f * x)); }

struct EpiStoreBf16 {
    static constexpr bool PERM = true, AFTER_DRAIN = false;
    bf16_t* O; int ldc;
    __device__ __forceinline__ void operator()(const f32x4 (&acc)[2][2][4][2], const Unit& u, int wr, int wc, int fr, int fq) const {
        const int row0 = u.pm * BM + wr * 64 + fr, col0 = u.pn * BM + wc * 32 + 8 * fq;
#pragma unroll
        for (int ai = 0; ai < 2; ++ai)
#pragma unroll
            for (int m = 0; m < 4; ++m) { bf16_t* rowp = O + (size_t)(row0 + ai * HALF + m * 16) * ldc + col0;
#pragma unroll
                for (int bj = 0; bj < 2; ++bj) { const f32x4 v0 = acc[ai][bj][m][0], v1 = acc[ai][bj][m][1];
                    u32x4 w; w.x = cvt_pk_bf16(v0[0], v0[1]); w.y = cvt_pk_bf16(v0[2], v0[3]); w.z = cvt_pk_bf16(v1[0], v1[1]); w.w = cvt_pk_bf16(v1[2], v1[3]);
                    *(u32x4*)(rowp + bj * HALF) = w; } }
    }
};
struct EpiSwiGLU {
    static constexpr bool PERM = true, AFTER_DRAIN = false;
    bf16_t* H; int ldh;
    __device__ __forceinline__ void operator()(const f32x4 (&acc)[2][2][4][2], const Unit& u, int wr, int wc, int fr, int fq) const {
        const int row0 = u.pm * BM + wr * 64 + fr, col0 = u.pn * HALF + wc * 32 + 8 * fq;
#pragma unroll
        for (int ai = 0; ai < 2; ++ai)
#pragma unroll
            for (int m = 0; m < 4; ++m) { bf16_t* rowp = H + (size_t)(row0 + ai * HALF + m * 16) * ldh + col0;
                float h[8];
#pragma unroll
                for (int n = 0; n < 2; ++n)
#pragma unroll
                    for (int e = 0; e < 4; ++e) { const float g = acc[ai][0][m][n][e], up = acc[ai][1][m][n][e]; h[4 * n + e] = g * fast_sigmoid(g) * up; }
                u32x4 w; w.x = cvt_pk_bf16(h[0], h[1]); w.y = cvt_pk_bf16(h[2], h[3]); w.z = cvt_pk_bf16(h[4], h[5]); w.w = cvt_pk_bf16(h[6], h[7]);
                *(u32x4*)rowp = w; }
    }
};
struct EpiGlu {
    static constexpr bool PERM = true, AFTER_DRAIN = false;
    const bf16_t* Gv; bf16_t* O; int ldc; const float* bias;
    __device__ __forceinline__ void operator()(const f32x4 (&acc)[2][2][4][2], const Unit& u, int wr, int wc, int fr, int fq) const {
        const int row0 = u.pm * BM + wr * 64 + fr, col0 = u.pn * BM + wc * 32 + 8 * fq;
        f32x4 bv[2][2];
#pragma unroll
        for (int bj = 0; bj < 2; ++bj)
#pragma unroll
            for (int n = 0; n < 2; ++n) bv[bj][n] = *(const f32x4*)(bias + col0 + bj * HALF + 4 * n);
#pragma unroll
        for (int ai = 0; ai < 2; ++ai) {
            u32x4 gall[4][2];
#pragma unroll
            for (int m = 0; m < 4; ++m)
#pragma unroll
                for (int bj = 0; bj < 2; ++bj) gall[m][bj] = *(const u32x4*)(Gv + (size_t)(row0 + ai * HALF + m * 16) * ldc + col0 + bj * HALF);
            asm volatile("" ::: "memory");
#pragma unroll
            for (int m = 0; m < 4; ++m) { const size_t off = (size_t)(row0 + ai * HALF + m * 16) * ldc + col0;
#pragma unroll
                for (int bj = 0; bj < 2; ++bj) { const u32x4 gw = gall[m][bj];
                    const f32x4 v0 = acc[ai][bj][m][0] + bv[bj][0], v1 = acc[ai][bj][m][1] + bv[bj][1];
                    u32x4 w;
                    w.x = cvt_pk_bf16(bf_lo(gw.x) * fast_sigmoid(v0[0]), bf_hi(gw.x) * fast_sigmoid(v0[1]));
                    w.y = cvt_pk_bf16(bf_lo(gw.y) * fast_sigmoid(v0[2]), bf_hi(gw.y) * fast_sigmoid(v0[3]));
                    w.z = cvt_pk_bf16(bf_lo(gw.z) * fast_sigmoid(v1[0]), bf_hi(gw.z) * fast_sigmoid(v1[1]));
                    w.w = cvt_pk_bf16(bf_lo(gw.w) * fast_sigmoid(v1[2]), bf_hi(gw.w) * fast_sigmoid(v1[3]));
                    *(u32x4*)(O + off + bj * HALF) = w; } }
            asm volatile("" ::: "memory"); }
    }
};

template <class Epi, class Sched, bool ALIGN_EPI = false, bool SP2 = false>
__device__ __forceinline__ void gemm_phase(PG8_LAS unsigned char* lds, const Gemm g, const Sched& S, const Epi& E, const int wid) {
    int lane_; asm volatile("v_mbcnt_lo_u32_b32 %0, -1, 0\n\tv_mbcnt_hi_u32_b32 %0, -1, %0" : "=v"(lane_));
    int wid_ = wid; asm volatile("" : "+s"(wid_));
    const int lane = lane_, tid = wid_ * 64 + lane, wr = wid_ >> 2, wc = wid_ & 3, fr = lane & 15, fq = lane >> 4;
    const int K = g.K, nt = K / BK;
    unsigned voffA[2], voffB[2];
#pragma unroll
    for (int i = 0; i < 2; ++i) { int R, C; stage_rc(tid * 16 + i * 8192, R, C); const int Rb = Epi::PERM ? ((R & ~31) + perm32(R & 31)) : R;
        voffA[i] = (unsigned)(R * K + C) * 2u; voffB[i] = (unsigned)(Rb * K + C) * 2u; }
    const size_t kstep = (size_t)(BK * 2);
    const size_t hstep = (size_t)HALF * K * 2;
    const size_t tstep = 2 * hstep;
    const unsigned ldsw = (unsigned)wid_ * 1024u;
    const int aoff = lds_byte(wr * 64 + fr, fq * 8), boff = lds_byte(wc * 32 + fr, fq * 8);
#define PG8_SA(b, h) (((b) * 2 + (h)) * HTB)
#define PG8_SB(b, h) ((4 + (b) * 2 + (h)) * HTB)
#define PG8_STAGE(bufoff, gbase, voff) do { _Pragma("unroll") for (int _i = 0; _i < 2; ++_i) \
        __builtin_amdgcn_global_load_lds((const unsigned*)((const char*)(gbase) + (voff)[_i]), (PG8_LAS unsigned*)(lds + (bufoff) + ldsw + _i * 8192), 16, 0, 0); } while (0)
#define PG8_LDA(dst, b, h) do { _Pragma("unroll") for (int m = 0; m < 4; ++m) _Pragma("unroll") for (int k = 0; k < 2; ++k) dst[m][k] = *(const PG8_LAS bf16x8*)(lds + PG8_SA(b, h) + aoff + m * 2048 + k * 1024); } while (0)
#define PG8_LDB(dst, b, h) do { _Pragma("unroll") for (int n = 0; n < 2; ++n) _Pragma("unroll") for (int k = 0; k < 2; ++k) dst[n][k] = *(const PG8_LAS bf16x8*)(lds + PG8_SB(b, h) + boff + n * 2048 + k * 1024); } while (0)
#define PG8_MMA(ai, bj, At, Bt) do { __builtin_amdgcn_s_setprio(1); _Pragma("unroll") for (int m = 0; m < 4; ++m) _Pragma("unroll") for (int n = 0; n < 2; ++n) _Pragma("unroll") for (int k = 0; k < 2; ++k) \
        acc[ai][bj][m][n] = __builtin_amdgcn_mfma_f32_16x16x32_bf16(Bt[n][k], At[m][k], acc[ai][bj][m][n], 0, 0, 0); __builtin_amdgcn_s_setprio(0); } while (0)
#define PG8_WAIT_V(n) asm volatile("s_waitcnt vmcnt(" #n ")" ::: "memory")
#define PG8_WAIT_L(n) asm volatile("s_waitcnt lgkmcnt(" #n ")" ::: "memory")
#define PG8_BAR __builtin_amdgcn_s_barrier()
#define PG8_SCHED __builtin_amdgcn_sched_barrier(0)
    Unit cur, nxt; int ui = 0;
    if (!S.next(0, cur)) return;
    f32x4 acc[2][2][4][2];
#pragma unroll
    for (int a = 0; a < 2; ++a)
#pragma unroll
        for (int b = 0; b < 2; ++b)
#pragma unroll
            for (int m = 0; m < 4; ++m)
#pragma unroll
                for (int n = 0; n < 2; ++n) acc[a][b][m][n] = (f32x4){0.f, 0.f, 0.f, 0.f};
    bf16x8 At[4][2], B0[2][2], B1[2][2];
    const char* cA = (const char*)g.A + (size_t)cur.pm * tstep; const char* cB = (const char*)g.Bt + (size_t)cur.pn * tstep;
    S.a_ready(cur);
    if constexpr (SP2) {
        PG8_STAGE(PG8_SB(0, 0), cB, voffB); PG8_STAGE(PG8_SB(0, 1), cB + hstep, voffB); PG8_STAGE(PG8_SA(0, 0), cA, voffA); PG8_STAGE(PG8_SA(0, 1), cA + hstep, voffA);
        if (wr == 1) PG8_BAR;
        PG8_WAIT_V(2); PG8_BAR;
        PG8_STAGE(PG8_SB(1, 0), cB + kstep, voffB); PG8_STAGE(PG8_SA(1, 0), cA + kstep, voffA); PG8_STAGE(PG8_SB(1, 1), cB + hstep + kstep, voffB);
        PG8_WAIT_V(6); PG8_BAR;
    } else {
        PG8_STAGE(PG8_SB(0, 0), cB, voffB); PG8_STAGE(PG8_SA(0, 0), cA, voffA); PG8_STAGE(PG8_SB(0, 1), cB + hstep, voffB); PG8_STAGE(PG8_SA(0, 1), cA + hstep, voffA);
        if (wr == 1) PG8_BAR;
        PG8_WAIT_V(4); PG8_BAR;
        PG8_STAGE(PG8_SB(1, 0), cB + kstep, voffB); PG8_STAGE(PG8_SA(1, 0), cA + kstep, voffA); PG8_STAGE(PG8_SB(1, 1), cB + hstep + kstep, voffB);
        PG8_WAIT_V(6); PG8_BAR;
    }
    for (;;) {
        const bool has_next = S.next(ui + 1, nxt);
        const char* nA = has_next ? (const char*)g.A + (size_t)nxt.pm * tstep : cA; const char* nB = has_next ? (const char*)g.Bt + (size_t)nxt.pn * tstep : cB;
        for (int t = 0; t < nt; t += 2) {
            const bool last = (t == nt - 2);
            const char* a1 = cA + (size_t)(t + 1) * kstep;
            const char* a2 = last ? nA : cA + (size_t)(t + 2) * kstep; const char* b2 = last ? nB : cB + (size_t)(t + 2) * kstep;
            const char* a3 = a2 + kstep; const char* b3 = b2 + kstep;
            if (last && has_next) S.a_ready(nxt);
            if constexpr (SP2) {
            PG8_LDB(B0, 0, 0); PG8_LDB(B1, 0, 1); PG8_SCHED; PG8_LDA(At, 0, 0); PG8_STAGE(PG8_SA(1, 1), a1 + hstep, voffA);
            PG8_WAIT_V(8); PG8_WAIT_L(0); PG8_BAR; PG8_MMA(0, 0, At, B0); PG8_MMA(0, 1, At, B1); PG8_BAR; PG8_SCHED;
            PG8_LDA(At, 0, 1); PG8_STAGE(PG8_SB(0, 0), b2, voffB); PG8_STAGE(PG8_SB(0, 1), b2 + hstep, voffB); PG8_STAGE(PG8_SA(0, 0), a2, voffA);
            PG8_WAIT_V(8); PG8_WAIT_L(0); PG8_BAR; PG8_MMA(1, 0, At, B0); PG8_MMA(1, 1, At, B1); PG8_BAR; PG8_SCHED;
            PG8_LDB(B0, 1, 0); PG8_LDB(B1, 1, 1); PG8_SCHED; PG8_LDA(At, 1, 0); PG8_STAGE(PG8_SA(0, 1), a2 + hstep, voffA);
            PG8_WAIT_V(8); PG8_WAIT_L(0); PG8_BAR; PG8_MMA(0, 0, At, B0); PG8_MMA(0, 1, At, B1); PG8_BAR; PG8_SCHED;
            PG8_LDA(At, 1, 1); PG8_STAGE(PG8_SB(1, 0), b3, voffB); PG8_STAGE(PG8_SB(1, 1), b3 + hstep, voffB); PG8_STAGE(PG8_SA(1, 0), a3, voffA);
            PG8_WAIT_V(8); PG8_WAIT_L(0); PG8_BAR; PG8_MMA(1, 0, At, B0); PG8_MMA(1, 1, At, B1); PG8_BAR; PG8_SCHED;
            } else {
            PG8_LDB(B0, 0, 0); PG8_SCHED; PG8_LDA(At, 0, 0); PG8_STAGE(PG8_SA(1, 1), a1 + hstep, voffA);
            PG8_WAIT_L(8); PG8_BAR; PG8_WAIT_L(0); PG8_MMA(0, 0, At, B0); PG8_BAR; PG8_SCHED;
            PG8_LDB(B1, 0, 1); PG8_STAGE(PG8_SB(0, 0), b2, voffB);
            PG8_BAR; PG8_WAIT_L(0); PG8_MMA(0, 1, At, B1); PG8_BAR;
            PG8_LDA(At, 0, 1); PG8_STAGE(PG8_SA(0, 0), a2, voffA);
            PG8_BAR; PG8_WAIT_L(0); PG8_MMA(1, 0, At, B0); PG8_BAR; PG8_SCHED;
            PG8_STAGE(PG8_SB(0, 1), b2 + hstep, voffB);
            PG8_WAIT_V(6); PG8_BAR; PG8_MMA(1, 1, At, B1); PG8_BAR;
            PG8_LDB(B0, 1, 0); PG8_SCHED; PG8_LDA(At, 1, 0); PG8_STAGE(PG8_SA(0, 1), a2 + hstep, voffA);
            PG8_WAIT_L(8); PG8_BAR; PG8_WAIT_L(0); PG8_MMA(0, 0, At, B0); PG8_BAR; PG8_SCHED;
            PG8_LDB(B1, 1, 1); PG8_STAGE(PG8_SB(1, 0), b3, voffB);
            PG8_BAR; PG8_WAIT_L(0); PG8_MMA(0, 1, At, B1); PG8_BAR;
            PG8_LDA(At, 1, 1); PG8_STAGE(PG8_SA(1, 0), a3, voffA);
            PG8_BAR; PG8_WAIT_L(0); PG8_MMA(1, 0, At, B0); PG8_BAR; PG8_SCHED;
            PG8_STAGE(PG8_SB(1, 1), b3 + hstep, voffB);
            PG8_WAIT_V(6); PG8_BAR; PG8_MMA(1, 1, At, B1); PG8_BAR;
            }
        }
        if constexpr (ALIGN_EPI) { if (wr == 0) PG8_BAR; }
        if constexpr (!Epi::AFTER_DRAIN) { E(acc, cur, wr, wc, fr, fq); S.done(cur); }
        if (!has_next) break;
#pragma unroll
        for (int a = 0; a < 2; ++a)
#pragma unroll
            for (int b = 0; b < 2; ++b)
#pragma unroll
                for (int m = 0; m < 4; ++m)
#pragma unroll
                    for (int n = 0; n < 2; ++n) acc[a][b][m][n] = (f32x4){0.f, 0.f, 0.f, 0.f};
        cur = nxt; cA = nA; cB = nB; ++ui;
        if constexpr (ALIGN_EPI) { if (wr == 1) PG8_BAR; }
    }
    PG8_WAIT_V(0);
    if constexpr (!ALIGN_EPI) { if (wr == 0) PG8_BAR; }
    PG8_BAR;
    if constexpr (Epi::AFTER_DRAIN) { E.fused(acc, cur, wr, wc, fr, fq, lds, wid, lane); S.done(cur); }
#undef PG8_SA
#undef PG8_SB
#undef PG8_STAGE
#undef PG8_LDA
#undef PG8_LDB
#undef PG8_MMA
#undef PG8_WAIT_V
#undef PG8_WAIT_L
#undef PG8_BAR
#undef PG8_SCHED
}
}

constexpr int NWAVES = 8;
#ifndef MK_SINGLE
#define MK_SINGLE 1
#endif

constexpr int SEQ = 8192, DM = 4096, DEPTH = 2, HD = 128, SSMC = 1024, NSBH = 12, NDLH = 12, SBW = 1536, DLW = 1536, INW = 10240, FFN = 11008, GUW = 2 * FFN;
constexpr int NGRP = 64, NST = 64, SGRP = 16;
constexpr int C_QSB = 0, C_KSB = 1536, C_VSB = 3072, C_QDL = 4608, C_KDL = 6144, C_VDL = 7680, C_USSM = 9216;
constexpr float RMS_EPS = 1e-6f;
constexpr float ATT_SCALE = 0.08838834764831845f;
constexpr int SSM_T = 256, SSM_LOG2T = 8, SSM_NCH = SEQ / SSM_T;
static_assert((1 << SSM_LOG2T) == SSM_T, "SSM_T");
constexpr int STEPS_PER_LAYER = 10, NSTEPS = 1 + DEPTH * STEPS_PER_LAYER;

constexpr size_t MiB = 1u << 20;
constexpr size_t WS_CTL = 0, CTL_ZERO_BYTES = 1 * MiB;
constexpr size_t WS_W = 3 * MiB, WL_BYTES = 372 * MiB;
constexpr size_t WO_IN = 0, WO_GLU = 80 * MiB, WO_OUT = 82 * MiB, WO_GU = 114 * MiB, WO_DN = 286 * MiB;
constexpr size_t WS_XN = 747 * MiB;
constexpr size_t WS_PROJ = 811 * MiB;
constexpr size_t WS_OSB = 971 * MiB;
constexpr size_t WS_H = 811 * MiB;
constexpr size_t WS_MIX = 995 * MiB;
constexpr size_t WS_F = 1059 * MiB;
constexpr size_t WS_X1 = 1123 * MiB;
constexpr size_t WS_ODL = 1251 * MiB;
constexpr size_t WS_G = 1323 * MiB;
constexpr size_t WS_OSSM = 1339 * MiB;
constexpr size_t WS_XE = 1355 * MiB;
constexpr size_t WS_STAT = 1357 * MiB;
constexpr size_t WS_TAB = 1 * MiB;
constexpr size_t WS_END = 1360 * MiB;
static_assert(WS_W + DEPTH * WL_BYTES <= WS_XN && WS_H + (size_t)SEQ * FFN * 2 <= WS_MIX && WS_PROJ + (size_t)SEQ * INW * 2 <= WS_OSB, "d_ws map");
constexpr int CW_TMO = 0, CW_CODE = 1, CW_BAR = 4096;

constexpr int WAVE_LDS = 18432;
constexpr int LDSCTL_OFF = 8 * WAVE_LDS, MISC_OFF = LDSCTL_OFF + 320;
constexpr int LDS_BYTES = 148480;
static_assert(MISC_OFF + 128 <= LDS_BYTES && 8 * WAVE_LDS >= 131072, "LDS map");

#define GAS __attribute__((address_space(1)))
#define LAS __attribute__((address_space(3)))
typedef unsigned short bf16;
typedef unsigned v4u __attribute__((ext_vector_type(4)));
typedef unsigned v2u __attribute__((ext_vector_type(2)));
typedef float f32x4 __attribute__((ext_vector_type(4)));
typedef float f32x2 __attribute__((ext_vector_type(2)));
typedef short bf16x8 __attribute__((ext_vector_type(8)));
typedef GAS unsigned gu32;
#define RLX_AGENT __ATOMIC_RELAXED, __HIP_MEMORY_SCOPE_AGENT
#define LDS_WAIT() asm volatile("s_waitcnt lgkmcnt(0)" ::: "memory")
#define VM_WAIT() asm volatile("s_waitcnt vmcnt(0)" ::: "memory")
__device__ __forceinline__ int fresh_lane() { int l; asm volatile("v_mbcnt_lo_u32_b32 %0, -1, 0\n\tv_mbcnt_hi_u32_b32 %0, -1, %0" : "=v"(l)); return l; }
__device__ __forceinline__ unsigned pk2(float lo, float hi) { return pg8::cvt_pk_bf16(lo, hi); }
__device__ __forceinline__ float bflo(unsigned w) { return __uint_as_float(w << 16); }
__device__ __forceinline__ float bfhi(unsigned w) { return __uint_as_float(w & 0xffff0000u); }
__device__ __forceinline__ float bf2f(bf16 h) { return __uint_as_float((unsigned)h << 16); }
__device__ __forceinline__ float wave_sum(float v) {
#pragma unroll
    for (int o = 1; o < 64; o <<= 1) v += __shfl_xor(v, o);
    return v;
}
__device__ __forceinline__ float wave_max(float v) {
#pragma unroll
    for (int o = 1; o < 64; o <<= 1) v = fmaxf(v, __shfl_xor(v, o));
    return v;
}
#define XB_TMO      128
#define XB_XCNT(j)  (256  + 64 * (j))
#define XB_XSUB(j)  (1280 + 64 * (j))
#define XB_XGEN(j)  (2304 + 64 * (j))
#define XB_TOP      3328
#define XB_TOPGEN   3392
#define XCD_BAR_WORDS 3456
#define XB_SPIN_CAP (1u << 18)

__device__ __forceinline__ unsigned xb_ld(unsigned* p)              { return __hip_atomic_load(p, __ATOMIC_RELAXED, __HIP_MEMORY_SCOPE_AGENT); }
__device__ __forceinline__ unsigned xb_add(unsigned* p, unsigned v) { return __hip_atomic_fetch_add(p, v, __ATOMIC_RELAXED, __HIP_MEMORY_SCOPE_AGENT); }
__device__ __forceinline__ unsigned xb_xcc_id() { return (unsigned)__builtin_amdgcn_s_getreg((3 << 11) | 20) & 0xFu; }
#define XB_SPIN(cond, bar) do { unsigned _sp = 0; while (cond) { __builtin_amdgcn_s_sleep(1); \
    if ((++_sp & 255u) == 0u) { if (xb_ld(&(bar)[XB_TMO])) break; if (_sp > XB_SPIN_CAP) { atomicAdd(&(bar)[XB_TMO], 1u); break; } } } } while (0)

struct XcdBarrier {
    unsigned* bar; unsigned x;
    int w;
    volatile LAS unsigned* st;
};

__device__ __forceinline__ XcdBarrier xcd_barrier_post(unsigned* bar, volatile LAS unsigned* st, int wave) {
    XcdBarrier b; b.bar = bar; b.x = xb_xcc_id(); b.st = st; b.w = wave;
    if (wave == 0 && fresh_lane() == 0) (void)xb_add(&bar[XB_XCNT(b.x)], 1u);
    return b;
}
__device__ __forceinline__ void xcd_barrier_complete(unsigned* bar, unsigned x, unsigned& nloc, unsigned& nx) {
    const unsigned G = gridDim.x * gridDim.y * gridDim.z;
    unsigned sum, cnt, mine, sp = 0u;
    for (;;) {
        sum = 0u; cnt = 0u; mine = 0u;
#pragma unroll
        for (unsigned j = 0; j < 16; ++j) { const unsigned c = xb_ld(&bar[XB_XCNT(j)]); sum += c; cnt += (c > 0u) ? 1u : 0u; mine = (j == x) ? c : mine; }
        if (sum == G) break;
        __builtin_amdgcn_s_sleep(1);
        if ((++sp & 255u) == 0u) { if (xb_ld(&bar[XB_TMO])) break; if (sp > XB_SPIN_CAP) { atomicAdd(&bar[XB_TMO], 1u); break; } }
    }
    nloc = mine > 0u ? mine : 1u; nx = cnt > 0u ? cnt : 1u;
}

__device__ __forceinline__ void xcd_barrier(const XcdBarrier& b) {
    asm volatile("s_waitcnt vmcnt(0)" ::: "memory");
    __syncthreads();
    if (b.w == 0 && fresh_lane() == 0) {
        unsigned* bar = b.bar;
        __builtin_amdgcn_s_waitcnt(0);
        unsigned nloc = b.st[0], nx = b.st[1];
        if (nloc == 0u) { xcd_barrier_complete(bar, b.x, nloc, nx); b.st[0] = nloc; b.st[1] = nx; }
        const unsigned old = xb_add(&bar[XB_XSUB(b.x)], 1u);
        const unsigned gen = old / nloc;
        if (old + 1u == (gen + 1u) * nloc) {
            __builtin_amdgcn_fence(__ATOMIC_RELEASE, "agent");
            asm volatile("s_waitcnt vmcnt(0)" ::: "memory");
            const unsigned og = xb_add(&bar[XB_TOP], 1u);
            const unsigned tg = og / nx;
            if (og + 1u == (tg + 1u) * nx) xb_add(&bar[XB_TOPGEN], 1u);
            else XB_SPIN(xb_ld(&bar[XB_TOPGEN]) == tg, bar);
            __builtin_amdgcn_fence(__ATOMIC_ACQUIRE, "agent");
            xb_add(&bar[XB_XGEN(b.x)], 1u);
            asm volatile("s_waitcnt vmcnt(0)" ::: "memory");
        } else {
            XB_SPIN(xb_ld(&bar[XB_XGEN(b.x)]) == gen, bar);
            __builtin_amdgcn_fence(__ATOMIC_ACQUIRE, "agent");
            asm volatile("s_waitcnt vmcnt(0)" ::: "memory");
        }
    }
    __syncthreads();
}

#ifndef USE_NT
#define USE_NT 1
#endif
#if USE_NT
#define NT_LD(p) __builtin_nontemporal_load(p)
#define NT_ST(p, v) __builtin_nontemporal_store(v, p)
#else
#define NT_LD(p) (*(p))
#define NT_ST(p, v) (*(p) = (v))
#endif
__device__ __forceinline__ void tr_tile(const float* W, int K, int N, bf16* WT, int k0, int n0, int orow0, LAS float* scr, int lane_) {
    int lane = lane_; asm volatile("" : "+v"(lane));
#pragma unroll 4
    for (int i = 0; i < 16; ++i) { const int kk = 4 * i + (lane >> 4), c = (lane & 15) * 4;
        const f32x4 v = *(const f32x4*)(W + (size_t)(k0 + kk) * N + n0 + c);
        LAS float* d = scr + kk * 65 + c; d[0] = v.x; d[1] = v.y; d[2] = v.z; d[3] = v.w; }
    LDS_WAIT(); asm volatile("" ::: "memory");
    const int c8 = lane & 7;
#pragma unroll
    for (int j = 0; j < 8; ++j) { const int n = (lane >> 3) + 8 * j; const LAS float* s = scr + (8 * c8) * 65 + n;
        v4u o; o.x = pk2(s[0], s[65]); o.y = pk2(s[130], s[195]); o.z = pk2(s[260], s[325]); o.w = pk2(s[390], s[455]);
        *(v4u*)(WT + (size_t)(orow0 + n) * K + k0 + 8 * c8) = o; }
    LDS_WAIT(); asm volatile("" ::: "memory");
}

struct ConvItem { const float* W; bf16* WT; int K, N, k0, n0, orow0; };
__device__ __forceinline__ void tr_load(const ConvItem& c, int lane_, f32x4 (&v)[16]) {
    int lane = lane_; asm volatile("" : "+v"(lane));
    const float* src = c.W + (size_t)(c.k0 + (lane >> 4)) * c.N + c.n0 + (lane & 15) * 4;
#pragma unroll
    for (int i = 0; i < 16; ++i) v[i] = NT_LD((const f32x4*)(src + (size_t)(4 * i) * c.N));
}
__device__ __forceinline__ void tr_store(const ConvItem& c, LAS float* scr, int lane_, const f32x4 (&v)[16]) {
    int lane = lane_; asm volatile("" : "+v"(lane));
#pragma unroll
    for (int i = 0; i < 16; ++i) { LAS float* d = scr + (4 * i + (lane >> 4)) * 65 + (lane & 15) * 4; d[0] = v[i].x; d[1] = v[i].y; d[2] = v[i].z; d[3] = v[i].w; }
    LDS_WAIT(); asm volatile("" ::: "memory");
    const int c8 = lane & 7;
#pragma unroll
    for (int j = 0; j < 8; ++j) { const int n = (lane >> 3) + 8 * j; const LAS float* s = scr + (8 * c8) * 65 + n;
        v4u o; o.x = pk2(s[0], s[65]); o.y = pk2(s[130], s[195]); o.z = pk2(s[260], s[325]); o.w = pk2(s[390], s[455]);
        *(v4u*)(c.WT + (size_t)(c.orow0 + n) * c.K + c.k0 + 8 * c8) = o; }
    LDS_WAIT(); asm volatile("" ::: "memory");
}
__device__ __forceinline__ f32x4 ld_row4(const float* p) { return NT_LD((const f32x4*)p); }
__device__ __forceinline__ f32x4 ld_row4(const bf16* p) { const v2u w = NT_LD((const v2u*)p); return (f32x4){bflo(w.x), bfhi(w.x), bflo(w.y), bfhi(w.y)}; }
__device__ __forceinline__ void st_row4(float* p, const f32x4& v) { NT_ST((f32x4*)p, v); }
__device__ __forceinline__ void st_row4(bf16* p, const f32x4& v) { v2u o; o.x = pk2(v.x, v.y); o.y = pk2(v.z, v.w); NT_ST((v2u*)p, o); }
template <typename TI, typename TO>
__device__ __forceinline__ void row_op(const TI* xin, const bf16* f, const float* gpost, TO* xout, const float* gpre, bf16* xn, int lane_) {
    int lane = lane_; asm volatile("" : "+v"(lane));
    f32x4 x[16];
    if (f) {
        v2u fw[16]; float ss = 0.f;
#pragma unroll
        for (int j = 0; j < 16; ++j) { fw[j] = *(const v2u*)(f + 4 * lane + 256 * j);
            const float a = bflo(fw[j].x), b = bfhi(fw[j].x), c = bflo(fw[j].y), d = bfhi(fw[j].y); ss += (a * a + b * b) + (c * c + d * d); }
        const float r1 = 1.0f / sqrtf(wave_sum(ss) * (1.0f / DM) + RMS_EPS);
#pragma unroll
        for (int j = 0; j < 16; ++j) { const f32x4 xv = ld_row4(xin + 4 * lane + 256 * j), gp = *(const f32x4*)(gpost + 4 * lane + 256 * j);
            x[j].x = xv.x + bflo(fw[j].x) * r1 * gp.x; x[j].y = xv.y + bfhi(fw[j].x) * r1 * gp.y; x[j].z = xv.z + bflo(fw[j].y) * r1 * gp.z; x[j].w = xv.w + bfhi(fw[j].y) * r1 * gp.w;
            if ((j & (sizeof(TI) == 2 ? 7 : 3)) == (sizeof(TI) == 2 ? 7 : 3)) asm volatile("" ::: "memory"); }
    } else {
#pragma unroll
        for (int j = 0; j < 16; ++j) x[j] = ld_row4(xin + 4 * lane + 256 * j);
    }
    if (xout) {
#pragma unroll
        for (int j = 0; j < 16; ++j) st_row4(xout + 4 * lane + 256 * j, x[j]);
    }
    if (xn) {
        float s2 = 0.f;
#pragma unroll
        for (int j = 0; j < 16; ++j) s2 += (x[j].x * x[j].x + x[j].y * x[j].y) + (x[j].z * x[j].z + x[j].w * x[j].w);
        const float r2 = 1.0f / sqrtf(wave_sum(s2) * (1.0f / DM) + RMS_EPS);
#pragma unroll
        for (int j = 0; j < 16; ++j) { const f32x4 gp = *(const f32x4*)(gpre + 4 * lane + 256 * j);
            v2u o; o.x = pk2(x[j].x * r2 * gp.x, x[j].y * r2 * gp.y); o.y = pk2(x[j].z * r2 * gp.z, x[j].w * r2 * gp.w);
            *(v2u*)(xn + 4 * lane + 256 * j) = o;
            if ((j & 3) == 3) asm volatile("" ::: "memory"); }
    }
}

__device__ __forceinline__ void gains_to_lds(const float* gpost, const float* gpre, LAS float* gl, int lane_, int wid) {
    int lane = lane_; asm volatile("" : "+v"(lane));
    __syncthreads();
#pragma unroll
    for (int q = 0; q < 2; ++q) { const int i = (q * NWAVES + wid) * 64 + lane;
        ((LAS f32x4*)gl)[i] = ((const f32x4*)gpost)[i]; if (gpre) ((LAS f32x4*)gl)[DM / 4 + i] = ((const f32x4*)gpre)[i]; }
    LDS_WAIT();
    __syncthreads();
}
__device__ __forceinline__ void raw_ld(const float* p, f32x4& r) { r = NT_LD((const f32x4*)p); }
__device__ __forceinline__ void raw_ld(const bf16* p, v2u& r) { r = NT_LD((const v2u*)p); }
__device__ __forceinline__ f32x4 raw_cv(const f32x4& r) { return r; }
__device__ __forceinline__ f32x4 raw_cv(const v2u& w) { return (f32x4){bflo(w.x), bfhi(w.x), bflo(w.y), bfhi(w.y)}; }
template <typename T> struct RawOf { typedef f32x4 type; };
template <> struct RawOf<bf16> { typedef v2u type; };
template <typename TI> struct RowRaw { v2u fw[16]; typename RawOf<TI>::type xw[16]; };
template <typename TI>
__device__ __forceinline__ void row_load(const TI* xin, const bf16* f, int lane_, RowRaw<TI>& R) {
    int lane = lane_; asm volatile("" : "+v"(lane));
#pragma unroll
    for (int j = 0; j < 16; ++j) R.fw[j] = NT_LD((const v2u*)(f + 4 * lane + 256 * j));
#pragma unroll
    for (int j = 0; j < 16; ++j) raw_ld(xin + 4 * lane + 256 * j, R.xw[j]);
}
template <typename TI, typename TO, bool HAS_XN>
__device__ __forceinline__ void row_finish(const RowRaw<TI>& R, const LAS float* gl, TO* xout, bf16* xn, int lane_) {
    int lane = lane_; asm volatile("" : "+v"(lane));
    float ss = 0.f;
#pragma unroll
    for (int j = 0; j < 16; ++j) { const float a = bflo(R.fw[j].x), b = bfhi(R.fw[j].x), c = bflo(R.fw[j].y), d = bfhi(R.fw[j].y); ss += (a * a + b * b) + (c * c + d * d); }
    const float r1 = 1.0f / sqrtf(wave_sum(ss) * (1.0f / DM) + RMS_EPS);
    f32x4 x[16]; float s2 = 0.f;
#pragma unroll
    for (int j = 0; j < 16; ++j) { const f32x4 xv = raw_cv(R.xw[j]), gp = *(const LAS f32x4*)(gl + 4 * lane + 256 * j);
        x[j].x = xv.x + bflo(R.fw[j].x) * r1 * gp.x; x[j].y = xv.y + bfhi(R.fw[j].x) * r1 * gp.y; x[j].z = xv.z + bflo(R.fw[j].y) * r1 * gp.z; x[j].w = xv.w + bfhi(R.fw[j].y) * r1 * gp.w;
        st_row4(xout + 4 * lane + 256 * j, x[j]);
        s2 += (x[j].x * x[j].x + x[j].y * x[j].y) + (x[j].z * x[j].z + x[j].w * x[j].w); }
    if (HAS_XN) {
        const float r2 = 1.0f / sqrtf(wave_sum(s2) * (1.0f / DM) + RMS_EPS);
#pragma unroll
        for (int j = 0; j < 16; ++j) { const f32x4 gp = *(const LAS f32x4*)(gl + DM + 4 * lane + 256 * j);
            v2u o; o.x = pk2(x[j].x * r2 * gp.x, x[j].y * r2 * gp.y); o.y = pk2(x[j].z * r2 * gp.z, x[j].w * r2 * gp.w);
            *(v2u*)(xn + 4 * lane + 256 * j) = o; }
    }
}
template <typename TI, typename TO, bool HAS_XN, bool PREFETCH>
__device__ __forceinline__ void row_phase(const TI* xin, const bf16* f, const LAS float* gl, TO* xout, bf16* xn, int gw, int ngw, int nrows, int lane) {
    if (!PREFETCH) {
        for (int m0 = gw; m0 < nrows; m0 += ngw) { const size_t o = (size_t)(m0 % SEQ) * DM; RowRaw<TI> a; row_load(xin + o, f + o, lane, a); asm volatile("" ::: "memory");
            row_finish<TI, TO, HAS_XN>(a, gl, xout + o, xn + o, lane); }
    } else {
        int m0 = gw; if (m0 >= nrows) return;
        RowRaw<TI> a, b; { const size_t o = (size_t)(m0 % SEQ) * DM; row_load(xin + o, f + o, lane, a); }
        for (;;) {
            const int m1 = m0 + ngw; if (m1 < nrows) { const size_t o = (size_t)(m1 % SEQ) * DM; row_load(xin + o, f + o, lane, b); }
            asm volatile("" ::: "memory");
            { const size_t o = (size_t)(m0 % SEQ) * DM; row_finish<TI, TO, HAS_XN>(a, gl, xout + o, xn + o, lane); }
            if (m1 >= nrows) break;
            const int m2 = m1 + ngw; if (m2 < nrows) { const size_t o = (size_t)(m2 % SEQ) * DM; row_load(xin + o, f + o, lane, a); }
            asm volatile("" ::: "memory");
            { const size_t o = (size_t)(m1 % SEQ) * DM; row_finish<TI, TO, HAS_XN>(b, gl, xout + o, xn + o, lane); }
            if (m2 >= nrows) break;
            m0 = m2;
        }
    }
}

__device__ __forceinline__ float dot128(const v4u (&q)[16], const bf16* kp) {
    float s0 = 0.f, s1 = 0.f;
#pragma unroll
    for (int i = 0; i < 16; ++i) { const v4u kv = *(const v4u*)(kp + 8 * i);
        s0 += bflo(q[i].x) * bflo(kv.x) + bflo(q[i].y) * bflo(kv.y) + bflo(q[i].z) * bflo(kv.z) + bflo(q[i].w) * bflo(kv.w);
        s1 += bfhi(q[i].x) * bfhi(kv.x) + bfhi(q[i].y) * bfhi(kv.y) + bfhi(q[i].z) * bfhi(kv.z) + bfhi(q[i].w) * bfhi(kv.w); }
    return s0 + s1;
}
constexpr float SB_STOP_N = -100.0f;
__device__ __forceinline__ void sb_naive(const bf16* P, bf16* OSB, int h, int t, int lane) {
    v4u q[16];
    { const bf16* qp = P + (size_t)t * INW + C_QSB + h * HD;
#pragma unroll
      for (int i = 0; i < 16; ++i) q[i] = *(const v4u*)(qp + 8 * i); }
    float o0 = 0.f, o1 = 0.f, R = 0.f;
    for (int base = t - 1; base >= 0; base -= 64) {
        const int s = base - lane; const bool valid = s >= 0; const int sc = valid ? s : 0;
        const float z = dot128(q, P + (size_t)sc * INW + C_KSB + h * HD) * ATT_SCALE;
        const float sp = fmaxf(z, 0.f) + __logf(1.0f + __expf(-fabsf(z)));
        const float lb = valid ? -sp : 0.f, ls = z - sp;
        float inc = lb;
#pragma unroll
        for (int o = 1; o < 64; o <<= 1) { const float tv = __shfl_up(inc, o); if (lane >= o) inc += tv; }
        const float a = valid ? __expf(ls + R + inc - lb) : 0.f;
        const float tot = __shfl(inc, 63);
        const int nk = base + 1 < 64 ? base + 1 : 64;
        for (int j = 0; j < nk; ++j) { const float aj = __shfl(a, j); const bf16* vp = P + (size_t)(base - j) * INW + C_VSB + h * HD;
            o0 += aj * bf2f(vp[lane]); o1 += aj * bf2f(vp[lane + 64]); }
        R += tot;
        if (R < SB_STOP_N) break;
    }
    bf16* op = OSB + (size_t)t * SBW + h * HD;
    op[lane] = (bf16)(pk2(o0, 0.f) & 0xffffu); op[lane + 64] = (bf16)(pk2(o1, 0.f) & 0xffffu);
}
__device__ __forceinline__ void dl_naive(const bf16* P, bf16* ODL, int h, int t, int lane) {
    v4u q[16];
    { const bf16* qp = P + (size_t)t * INW + C_QDL + h * HD;
#pragma unroll
      for (int i = 0; i < 16; ++i) q[i] = *(const v4u*)(qp + 8 * i); }
    float o0 = 0.f, o1 = 0.f, m = -1e30f, l = 0.f;
    for (int b = 0; b < 3; ++b) { const int d = b == 0 ? 1 : (b == 1 ? 4 : 16);
        for (int it = 0; it < 3; ++it) {
            const int j = it * 64 + lane, pos = t - j * d; const bool valid = (j <= 128) && (pos >= 0); const int pc = valid ? pos : 0;
            if (t - it * 64 * d < 0) break;
            const float s = dot128(q, P + (size_t)pc * INW + C_KDL + h * HD) * ATT_SCALE;
            const float tm = wave_max(valid ? s : -1e30f);
            const float mn = fmaxf(m, tm), alpha = __expf(m - mn);
            const float p = valid ? __expf(s - mn) : 0.f;
            l = l * alpha + wave_sum(p); o0 *= alpha; o1 *= alpha; m = mn;
            const int nj = it == 2 ? 1 : 64;
            for (int jj = 0; jj < nj; ++jj) { const int pp = t - (it * 64 + jj) * d; if (pp < 0) break;
                const float pj = __shfl(p, jj); const bf16* vp = P + (size_t)pp * INW + C_VDL + h * HD;
                o0 += pj * bf2f(vp[lane]); o1 += pj * bf2f(vp[lane + 64]); }
        }
    }
    const float rl = 1.0f / l;
    bf16* op = ODL + (size_t)t * DLW + h * HD;
    op[lane] = (bf16)(pk2(o0 * rl, 0.f) & 0xffffu); op[lane + 64] = (bf16)(pk2(o1 * rl, 0.f) & 0xffffu);
}

#ifndef EXP_OLDSSM
#define EXP_OLDSSM 0
#endif
#ifndef EXP_MFMA_PAD
#define EXP_MFMA_PAD 0
#endif
#ifndef EXP_UGLOBAL
#define EXP_UGLOBAL 0
#endif
struct SsmW { const float *lam_re, *lam_im, *log_dt, *b_re, *b_im, *c_re, *c_im, *dsk; };
struct SsmRegs { float ar, ai, atr, ati, dsk; bf16x8 bfr[8]; bf16x8 cf[4]; };
template <bool PASS2>
__device__ __forceinline__ void ssm_build(const SsmW& w, int g, int lane_, SsmRegs& R) {
    int lane = lane_; asm volatile("" : "+v"(lane));
    const float a_re = fminf(w.lam_re[g * NST + lane], -1e-4f), a_im = w.lam_im[g * NST + lane], dt = expf(w.log_dt[g]);
    const float mag = expf(dt * a_re), ang = dt * a_im;
    const float ar = mag * cosf(ang), ai = mag * sinf(ang);
    const float den = a_re * a_re + a_im * a_im, nr = ar - 1.0f;
    const float f_re = (nr * a_re + ai * a_im) / den, f_im = (ai * a_re - nr * a_im) / den;
    R.ar = ar; R.ai = ai;
    float tr = ar, ti = ai;
#pragma unroll
    for (int s = 0; s < SSM_LOG2T; ++s) { const float n2r = tr * tr - ti * ti, n2i = 2.0f * tr * ti; tr = n2r; ti = n2i; }
    R.atr = tr; R.ati = ti;
    const int n16 = lane & 15, kq = lane >> 4;
#pragma unroll
    for (int j = 0; j < 8; ++j) { const int np = (16 * j + n16) & 63; const float fr = __shfl(f_re, np), fi = __shfl(f_im, np);
        const float* brp = w.b_re + (size_t)(g * NST + np) * SGRP + 8 * (kq & 1); const float* bip = w.b_im + (size_t)(g * NST + np) * SGRP + 8 * (kq & 1);
        const f32x4 r0 = *(const f32x4*)brp, r1 = *(const f32x4*)(brp + 4), i0 = *(const f32x4*)bip, i1 = *(const f32x4*)(bip + 4);
        float v[8];
#pragma unroll
        for (int e = 0; e < 4; ++e) { v[e] = j < 4 ? fr * r0[e] - fi * i0[e] : fr * i0[e] + fi * r0[e]; v[4 + e] = j < 4 ? fr * r1[e] - fi * i1[e] : fr * i1[e] + fi * r1[e]; }
        v4u o; o.x = pk2(v[0], v[1]); o.y = pk2(v[2], v[3]); o.z = pk2(v[4], v[5]); o.w = pk2(v[6], v[7]);
        if (kq >= 2) o = (v4u){0u, 0u, 0u, 0u};
        R.bfr[j] = __builtin_bit_cast(bf16x8, o); }
    if (PASS2) {
#pragma unroll
        for (int kk = 0; kk < 4; ++kk) { const size_t co = (size_t)(g * SGRP + n16) * NST + kk * 16 + 4 * kq;
            const f32x4 cr = *(const f32x4*)(w.c_re + co), ci = *(const f32x4*)(w.c_im + co);
            v4u o; o.x = pk2(cr.x, -ci.x); o.y = pk2(cr.y, -ci.y); o.z = pk2(cr.z, -ci.z); o.w = pk2(cr.w, -ci.w);
            R.cf[kk] = __builtin_bit_cast(bf16x8, o); }
        R.dsk = w.dsk[g * SGRP + n16];
    }
}
constexpr int BU_PITCH = 20;
template <bool PASS2>
__device__ __forceinline__ void ssm_unit(const bf16* P, const SsmW& w, float* xe, bf16* Gout, int g, int ch, LAS unsigned char* wl, int lane_) {
    int lane = lane_; asm volatile("" : "+v"(lane));
    const int tb = ch * SSM_T;
    LAS float* BU = (LAS float*)wl;
    LAS bf16* X = (LAS bf16*)wl;
    LAS bf16* UA = (LAS bf16*)(wl + 128 * BU_PITCH * 4);
    static_assert(128 * BU_PITCH * 4 + SSM_T * 32 <= WAVE_LDS, "S5 LDS map");
        const bf16* src = P + (size_t)(tb + (lane >> 1)) * INW + C_USSM + g * SGRP + 8 * (lane & 1);
        v4u s4[SSM_T / 32];
#pragma unroll
        for (int q = 0; q < SSM_T / 32; ++q) s4[q] = *(const v4u*)(src + (size_t)q * 32 * INW);
    f32x2 e0[32];
    if (PASS2) {
#pragma unroll
        for (int q = 0; q < 32; ++q) { const int j = q < ch ? q : (ch > 0 ? ch - 1 : 0); e0[q] = *(const f32x2*)(xe + ((size_t)(j * NGRP + g) * NST + lane) * 2); }
    }
    SsmRegs R; ssm_build<PASS2>(w, g, lane, R);
#pragma unroll
        for (int q = 0; q < SSM_T / 32; ++q) *(LAS v4u*)(UA + (q * 32 + (lane >> 1)) * 16 + 8 * (lane & 1)) = s4[q];
    const int n16 = lane & 15, kq = lane >> 4;
    const float ar = R.ar, ai = R.ai;
    float xr = 0.f, xi = 0.f;
    if (PASS2) {
#pragma unroll
        for (int q = 0; q < 32; ++q) if (q < ch) { const float nr = R.atr * xr - R.ati * xi + e0[q].x, ni = R.atr * xi + R.ati * xr + e0[q].y; xr = nr; xi = ni; }
        for (int j0 = 32; j0 < ch; j0 += 32) { f32x2 e[32];
#pragma unroll
            for (int q = 0; q < 32; ++q) { const int j = j0 + q < ch ? j0 + q : ch - 1; e[q] = *(const f32x2*)(xe + ((size_t)(j * NGRP + g) * NST + lane) * 2); }
#pragma unroll
            for (int q = 0; q < 32; ++q) if (j0 + q < ch) { const float nr = R.atr * xr - R.ati * xi + e[q].x, ni = R.atr * xi + R.ati * xr + e[q].y; xr = nr; xi = ni; } }
    }
    VM_WAIT(); LDS_WAIT(); asm volatile("" ::: "memory");
    for (int blk = 0; blk < SSM_T / 16; ++blk) {
        v4u aw = *(const LAS v4u*)(UA + (blk * 16 + n16) * 16 + 8 * (kq & 1));
        LDS_WAIT(); asm volatile("" ::: "memory");
        if (kq >= 2) aw = (v4u){0u, 0u, 0u, 0u};
        const bf16x8 af = __builtin_bit_cast(bf16x8, aw);
        f32x4 dd[8];
#pragma unroll
        for (int j = 0; j < 8; ++j) dd[j] = __builtin_amdgcn_mfma_f32_16x16x32_bf16(af, R.bfr[j], (f32x4){0.f, 0.f, 0.f, 0.f}, 0, 0, 0);
        asm volatile("" : "+v"(dd[0]), "+v"(dd[1]), "+v"(dd[2]), "+v"(dd[3]), "+v"(dd[4]), "+v"(dd[5]), "+v"(dd[6]), "+v"(dd[7]));
#pragma unroll
        for (int j = 0; j < 8; ++j) *(LAS f32x4*)(BU + (16 * j + n16) * BU_PITCH + 4 * kq) = dd[j];
        LDS_WAIT(); asm volatile("" ::: "memory");
        f32x4 br[4], bi[4];
#pragma unroll
        for (int q = 0; q < 4; ++q) { br[q] = *(const LAS f32x4*)(BU + lane * BU_PITCH + 4 * q); bi[q] = *(const LAS f32x4*)(BU + (64 + lane) * BU_PITCH + 4 * q); }
        LDS_WAIT(); asm volatile("" ::: "memory");
#pragma unroll
        for (int tt = 0; tt < 16; ++tt) { const float nr = ar * xr - ai * xi + br[tt >> 2][tt & 3], ni = ar * xi + ai * xr + bi[tt >> 2][tt & 3]; xr = nr; xi = ni;
            if (PASS2) { *(LAS unsigned*)(X + tt * 128 + 2 * lane) = pk2(xr, xi);
                if ((tt & 7) == 7) { LDS_WAIT(); asm volatile("" ::: "memory"); } } }
        if (PASS2) {
            LDS_WAIT(); asm volatile("" ::: "memory");
            f32x4 acc = (f32x4){0.f, 0.f, 0.f, 0.f};
            bf16x8 xf[4];
#pragma unroll
            for (int kk = 0; kk < 4; ++kk) xf[kk] = *(const LAS bf16x8*)((LAS unsigned char*)X + n16 * 256 + kk * 64 + kq * 16);
            bf16 uu[4];
#pragma unroll
            for (int r = 0; r < 4; ++r) uu[r] = UA[(blk * 16 + 4 * kq + r) * 16 + n16];
            LDS_WAIT(); asm volatile("" ::: "memory");
#pragma unroll
            for (int kk = 0; kk < 4; ++kk) acc = __builtin_amdgcn_mfma_f32_16x16x32_bf16(xf[kk], R.cf[kk], acc, 0, 0, 0);
#pragma unroll
            for (int r = 0; r < 4; ++r) { const float u = bf2f(uu[r]);
                const float y = acc[r] + R.dsk * u;
                const float th = 1.0f - 2.0f * __builtin_amdgcn_rcpf(1.0f + __expf(2.0f * 0.7978845608028654f * (y + 0.044715f * y * y * y)));
                UA[(blk * 16 + 4 * kq + r) * 16 + n16] = (bf16)(pk2(0.5f * y * (1.0f + th), 0.f) & 0xffffu); }
        }
        LDS_WAIT(); asm volatile("" ::: "memory");
    }
    if (PASS2) {
        v4u o4[SSM_T / 32];
#pragma unroll
        for (int q = 0; q < SSM_T / 32; ++q) o4[q] = *(const LAS v4u*)(UA + (q * 32 + (lane >> 1)) * 16 + 8 * (lane & 1));
        LDS_WAIT(); asm volatile("" ::: "memory");
        bf16* dst = Gout + (size_t)(tb + (lane >> 1)) * SSMC + g * SGRP + 8 * (lane & 1);
#pragma unroll
        for (int q = 0; q < SSM_T / 32; ++q) *(v4u*)(dst + (size_t)q * 32 * SSMC) = o4[q];
    }
    if (!PASS2) *(f32x2*)(xe + ((size_t)(ch * NGRP + g) * NST + lane) * 2) = (f32x2){xr, xi};
}

#if EXP_OLDSSM
struct SsmWOld { const float *lam_re, *lam_im, *log_dt, *b_re, *b_im, *c_re, *c_im, *dsk; };
__device__ __forceinline__ void ssm_params_old(const SsmWOld& w, int g, int n, float& ar, float& ai, float (&bre)[16], float (&bim)[16]) {
    const float a_re = fminf(w.lam_re[g * NST + n], -1e-4f), a_im = w.lam_im[g * NST + n], dt = expf(w.log_dt[g]);
    const float mag = expf(dt * a_re), ang = dt * a_im;
    ar = mag * cosf(ang); ai = mag * sinf(ang);
    const float den = a_re * a_re + a_im * a_im, nr = ar - 1.0f;
    const float f_re = (nr * a_re + ai * a_im) / den, f_im = (ai * a_re - nr * a_im) / den;
#pragma unroll
    for (int c4 = 0; c4 < 4; ++c4) { const f32x4 br = *(const f32x4*)(w.b_re + (size_t)(g * NST + n) * SGRP + 4 * c4), bi = *(const f32x4*)(w.b_im + (size_t)(g * NST + n) * SGRP + 4 * c4);
#pragma unroll
        for (int e = 0; e < 4; ++e) { bre[4 * c4 + e] = f_re * br[e] - f_im * bi[e]; bim[4 * c4 + e] = f_re * bi[e] + f_im * br[e]; } }
}
__device__ __forceinline__ void ssm_stage_u_old(const bf16* P, int g, int tb, LAS unsigned char* wl, int lane) {
#pragma unroll
    for (int rr = 0; rr < 2; ++rr) { const int t = 2 * lane + rr; const bf16* up = P + (size_t)(tb + t) * INW + C_USSM + g * SGRP;
        const v4u a = *(const v4u*)up, b = *(const v4u*)(up + 8);
        LAS f32x4* d = (LAS f32x4*)(wl + t * 64);
        d[0] = (f32x4){bflo(a.x), bfhi(a.x), bflo(a.y), bfhi(a.y)}; d[1] = (f32x4){bflo(a.z), bfhi(a.z), bflo(a.w), bfhi(a.w)};
        d[2] = (f32x4){bflo(b.x), bfhi(b.x), bflo(b.y), bfhi(b.y)}; d[3] = (f32x4){bflo(b.z), bfhi(b.z), bflo(b.w), bfhi(b.w)}; }
    LDS_WAIT(); asm volatile("" ::: "memory");
}
__device__ __forceinline__ void ssm_step_old(const LAS unsigned char* wl, int t, float ar, float ai, const float (&bre)[16], const float (&bim)[16], float& xr, float& xi) {
    const LAS f32x4* up = (const LAS f32x4*)(wl + t * 64);
    float br = 0.f, bi = 0.f;
#pragma unroll
    for (int c4 = 0; c4 < 4; ++c4) { const f32x4 u = up[c4];
#pragma unroll
        for (int e = 0; e < 4; ++e) { br += bre[4 * c4 + e] * u[e]; bi += bim[4 * c4 + e] * u[e]; } }
    const float nr = ar * xr - ai * xi + br, ni = ar * xi + ai * xr + bi; xr = nr; xi = ni;
}
__device__ __forceinline__ void ssm_pass1_old(const bf16* P, const SsmWOld& w, float* xe, int g, int ch, LAS unsigned char* wl, int lane_) {
    int lane = lane_; asm volatile("" : "+v"(lane));
    float ar, ai, bre[16], bim[16]; ssm_params_old(w, g, lane, ar, ai, bre, bim);
    ssm_stage_u_old(P, g, ch * SSM_T, wl, lane);
    float xr = 0.f, xi = 0.f;
    for (int t = 0; t < SSM_T; ++t) ssm_step_old(wl, t, ar, ai, bre, bim, xr, xi);
    *(f32x2*)(xe + ((size_t)(ch * NGRP + g) * NST + lane) * 2) = (f32x2){xr, xi};
    LDS_WAIT(); asm volatile("" ::: "memory");
}
__device__ __forceinline__ void ssm_pass2_old(const bf16* P, const SsmWOld& w, const float* xe, bf16* Gout, int g, int ch, LAS unsigned char* wl, int lane_) {
    int lane = lane_; asm volatile("" : "+v"(lane));
    float ar, ai, bre[16], bim[16]; ssm_params_old(w, g, lane, ar, ai, bre, bim);
    float tr = ar, ti = ai;
#pragma unroll
    for (int s = 0; s < SSM_LOG2T; ++s) { const float nr = tr * tr - ti * ti, ni = 2.0f * tr * ti; tr = nr; ti = ni; }
    float xr = 0.f, xi = 0.f;
    for (int j = 0; j < ch; ++j) { const f32x2 e = *(const f32x2*)(xe + ((size_t)(j * NGRP + g) * NST + lane) * 2);
        const float nr = tr * xr - ti * xi + e.x, ni = tr * xi + ti * xr + e.y; xr = nr; xi = ni; }
    const int tb = ch * SSM_T;
    ssm_stage_u_old(P, g, tb, wl, lane);
    const int c = lane & 15, kq = lane >> 4;
    bf16x8 cf[4];
#pragma unroll
    for (int kk = 0; kk < 4; ++kk) { const float* src = (kk < 2 ? w.c_re : w.c_im) + (size_t)(g * SGRP + c) * NST + (kk & 1) * 32 + 8 * kq;
        const f32x4 v0 = *(const f32x4*)src, v1 = *(const f32x4*)(src + 4); const float sg = kk < 2 ? 1.0f : -1.0f;
        v4u pkd; pkd.x = pk2(sg * v0.x, sg * v0.y); pkd.y = pk2(sg * v0.z, sg * v0.w); pkd.z = pk2(sg * v1.x, sg * v1.y); pkd.w = pk2(sg * v1.z, sg * v1.w);
        cf[kk] = __builtin_bit_cast(bf16x8, pkd); }
    const float dsk = w.dsk[g * SGRP + c];
    LAS bf16* X = (LAS bf16*)(wl + 8192);
    for (int blk = 0; blk < SSM_T / 16; ++blk) {
#pragma unroll 4
        for (int tt = 0; tt < 16; ++tt) { ssm_step_old(wl, blk * 16 + tt, ar, ai, bre, bim, xr, xi);
            const unsigned pkx = pk2(xr, xi); X[tt * 128 + lane] = (bf16)(pkx & 0xffffu); X[tt * 128 + 64 + lane] = (bf16)(pkx >> 16); }
        LDS_WAIT(); asm volatile("" ::: "memory");
        f32x4 acc = (f32x4){0.f, 0.f, 0.f, 0.f};
#pragma unroll
        for (int kk = 0; kk < 4; ++kk) { const bf16x8 af = *(const LAS bf16x8*)(wl + 8192 + c * 256 + kk * 64 + kq * 16);
            acc = __builtin_amdgcn_mfma_f32_16x16x32_bf16(af, cf[kk], acc, 0, 0, 0); }
#pragma unroll
        for (int r = 0; r < 4; ++r) { const int t = blk * 16 + 4 * kq + r;
#if EXP_UGLOBAL
            const float u = bf2f(P[(size_t)(tb + t) * INW + C_USSM + g * SGRP + c]);
#else
            const float u = ((const LAS float*)wl)[t * 16 + c];
#endif

            const float y = acc[r] + dsk * u;
            const float th = 1.0f - 2.0f * __builtin_amdgcn_rcpf(1.0f + __expf(2.0f * 0.7978845608028654f * (y + 0.044715f * y * y * y)));
            const float gl = 0.5f * y * (1.0f + th);
            Gout[(size_t)(tb + t) * SSMC + g * SGRP + c] = (bf16)(pk2(gl, 0.f) & 0xffffu); }
        LDS_WAIT(); asm volatile("" ::: "memory");
    }
}

#endif
template <int NCH>
__device__ __forceinline__ void seg_norm(const bf16* src, const float* gain, bf16* dst, int lane_) {
    int lane = lane_; asm volatile("" : "+v"(lane));
    v4u a[NCH]; float ss = 0.f;
#pragma unroll
    for (int i = 0; i < NCH; ++i) { a[i] = *(const v4u*)(src + 8 * lane + 512 * i);
        ss += (bflo(a[i].x) * bflo(a[i].x) + bfhi(a[i].x) * bfhi(a[i].x)) + (bflo(a[i].y) * bflo(a[i].y) + bfhi(a[i].y) * bfhi(a[i].y))
            + (bflo(a[i].z) * bflo(a[i].z) + bfhi(a[i].z) * bfhi(a[i].z)) + (bflo(a[i].w) * bflo(a[i].w) + bfhi(a[i].w) * bfhi(a[i].w)); }
    const float r = 1.0f / sqrtf(wave_sum(ss) * (1.0f / (NCH * 512)) + RMS_EPS);
#pragma unroll
    for (int i = 0; i < NCH; ++i) { const f32x4 g0 = *(const f32x4*)(gain + 8 * lane + 512 * i), g1 = *(const f32x4*)(gain + 8 * lane + 512 * i + 4);
        v4u o; o.x = pk2(bflo(a[i].x) * r * g0.x, bfhi(a[i].x) * r * g0.y); o.y = pk2(bflo(a[i].y) * r * g0.z, bfhi(a[i].y) * r * g0.w);
        o.z = pk2(bflo(a[i].z) * r * g1.x, bfhi(a[i].z) * r * g1.y); o.w = pk2(bflo(a[i].w) * r * g1.z, bfhi(a[i].w) * r * g1.w);
        *(v4u*)(dst + 8 * lane + 512 * i) = o; }
}


typedef float f32x16 __attribute__((ext_vector_type(16)));
typedef short s16x4 __attribute__((ext_vector_type(4)));
__device__ __forceinline__ int crow(int r, int hi) { return (r & 3) + 8 * (r >> 2) + 4 * hi; }
__device__ __forceinline__ int v_st(int k, int c) { const int kk = (k & ~0xC) | ((k & 4) << 1) | ((k & 8) >> 1); return ((kk >> 3) * 4 + (c >> 5)) * 512 + ((kk & 7) * 32 + (c & 31)) * 2; }
__device__ __forceinline__ int v_rd_base(int lane) { return ((lane & 3) << 3) | (((lane >> 2) & 3) << 6) | (((lane >> 4) & 1) << 5) | (((lane >> 5) & 1) << 8); }
constexpr int v_rd_off(int d0, int ks, int half) { return d0 * 512 + ks * 4096 + half * 2048; }
template <int OFF> __device__ __forceinline__ s16x4 tr_read(int vb) {
    s16x4 r; asm volatile("ds_read_b64_tr_b16 %0, %1 offset:%2" : "=&v"(r) : "v"(vb), "i"(OFF) : "memory"); return r;
}
template <int D0> __device__ __forceinline__ void pv_one(f32x16& od, int vb, bf16x8 pa0, bf16x8 pa1, bf16x8 pa2, bf16x8 pa3) {
    const s16x4 l0 = tr_read<v_rd_off(D0, 0, 0)>(vb), h0 = tr_read<v_rd_off(D0, 0, 1)>(vb), l1 = tr_read<v_rd_off(D0, 1, 0)>(vb), h1 = tr_read<v_rd_off(D0, 1, 1)>(vb);
    const s16x4 l2 = tr_read<v_rd_off(D0, 2, 0)>(vb), h2 = tr_read<v_rd_off(D0, 2, 1)>(vb), l3 = tr_read<v_rd_off(D0, 3, 0)>(vb), h3 = tr_read<v_rd_off(D0, 3, 1)>(vb);
    asm volatile("s_waitcnt lgkmcnt(0)" ::: "memory"); __builtin_amdgcn_sched_barrier(0);
#define PKV(L, H) (bf16x8){L[0], L[1], L[2], L[3], H[0], H[1], H[2], H[3]}
    od = __builtin_amdgcn_mfma_f32_32x32x16_bf16(pa0, PKV(l0, h0), od, 0, 0, 0);
    od = __builtin_amdgcn_mfma_f32_32x32x16_bf16(pa1, PKV(l1, h1), od, 0, 0, 0);
    od = __builtin_amdgcn_mfma_f32_32x32x16_bf16(pa2, PKV(l2, h2), od, 0, 0, 0);
    od = __builtin_amdgcn_mfma_f32_32x32x16_bf16(pa3, PKV(l3, h3), od, 0, 0, 0);
#undef PKV
}
__device__ __forceinline__ void pack_p(const f32x16& p0, const f32x16& p1, bf16x8& pa0, bf16x8& pa1, bf16x8& pa2, bf16x8& pa3) {
#define PK4(P, BASE, OUT) do { const unsigned a0 = pk2(P[BASE + 0], P[BASE + 1]), a1 = pk2(P[BASE + 2], P[BASE + 3]), b0 = pk2(P[BASE + 4], P[BASE + 5]), b1 = pk2(P[BASE + 6], P[BASE + 7]); \
        const auto r0 = __builtin_amdgcn_permlane32_swap(a0, b0, false, false); const auto r1 = __builtin_amdgcn_permlane32_swap(a1, b1, false, false); \
        v4u w = {r0[0], r1[0], r0[1], r1[1]}; OUT = __builtin_bit_cast(bf16x8, w); } while (0)
    PK4(p0, 0, pa0); PK4(p0, 8, pa1); PK4(p1, 0, pa2); PK4(p1, 8, pa3);
#undef PK4
}
#ifndef K_VIA_LDS
#define K_VIA_LDS 1
#endif
#ifndef V_FIRST_N
#define V_FIRST_N 5
#endif
constexpr int V_FIRST = V_FIRST_N;
struct VPend { v4u vv[16 - V_FIRST]; };
__device__ __forceinline__ void tile_qk(const bf16* P, int rowb, int rstride, int kcol, int vcol, const bf16x8 (&qr)[8], LAS unsigned char* wl, int lane, f32x16& p0, f32x16& p1, VPend& pend) {
    const int r32 = lane & 31, hi = lane >> 5, lq = lane >> 4, c = (lane & 15) * 8;
    const unsigned voff = (unsigned)(lq * rstride) * INW + vcol + c;
    LAS unsigned char* const vdst = wl + (c >> 5) * 512 + (lq * 32 + (c & 31)) * 2;
#if K_VIA_LDS
    const unsigned koff = (unsigned)(lq * rstride) * INW + kcol + c;
    v4u kw[16];
#pragma unroll
    for (int j = 0; j < 16; ++j) { const bf16* rowp = P + (size_t)(rowb + 4 * j * rstride) * INW; kw[j] = *(const v4u*)(rowp + koff); }
    v4u va[V_FIRST];
#pragma unroll
    for (int j = 0; j < V_FIRST; ++j) { const bf16* rowp = P + (size_t)(rowb + 4 * j * rstride) * INW; va[j] = *(const v4u*)(rowp + voff); }
    asm volatile("" ::: "memory");
    { LAS unsigned char* const kdst = wl + lq * 272 + (lane & 15) * 16;
#pragma unroll
      for (int j = 0; j < 16; ++j) *(LAS v4u*)(kdst + j * 4 * 272) = kw[j]; }
    LDS_WAIT(); asm volatile("" ::: "memory");
    bf16x8 kf0[8], kf1[8];
    { const LAS unsigned char* const ksrc = wl + r32 * 272 + hi * 16;
#pragma unroll
      for (int d0 = 0; d0 < 8; ++d0) { kf0[d0] = *(const LAS bf16x8*)(ksrc + d0 * 32); kf1[d0] = *(const LAS bf16x8*)(ksrc + 32 * 272 + d0 * 32); } }
    LDS_WAIT(); asm volatile("" ::: "memory");
#else
    const bf16* const k0p = P + (size_t)rowb * INW; const bf16* const k1p = P + (size_t)(rowb + 32 * rstride) * INW;
    const unsigned koff = (unsigned)(r32 * rstride) * INW + kcol + hi * 8;
    bf16x8 kf0[8], kf1[8];
#pragma unroll
    for (int d0 = 0; d0 < 8; ++d0) { kf0[d0] = *(const bf16x8*)(k0p + koff + d0 * 16); kf1[d0] = *(const bf16x8*)(k1p + koff + d0 * 16); }
    v4u va[V_FIRST];
#pragma unroll
    for (int j = 0; j < V_FIRST; ++j) { const bf16* rowp = P + (size_t)(rowb + 4 * j * rstride) * INW; va[j] = *(const v4u*)(rowp + voff); }
    asm volatile("" ::: "memory");
#endif
    p0 = (f32x16){}; p1 = (f32x16){};
#pragma unroll
    for (int d0 = 0; d0 < 8; ++d0) { p0 = __builtin_amdgcn_mfma_f32_32x32x16_bf16(kf0[d0], qr[d0], p0, 0, 0, 0); p1 = __builtin_amdgcn_mfma_f32_32x32x16_bf16(kf1[d0], qr[d0], p1, 0, 0, 0); }
#pragma unroll
    for (int j = 0; j < V_FIRST; ++j) *(LAS v4u*)(vdst + ((j & 1) + 2 * (j >> 2)) * 2048 + ((j >> 1) & 1) * 256) = va[j];
#pragma unroll
    for (int j = V_FIRST; j < 16; ++j) { const bf16* rowp = P + (size_t)(rowb + 4 * j * rstride) * INW; pend.vv[j - V_FIRST] = *(const v4u*)(rowp + voff); }
    asm volatile("" ::: "memory");
}
__device__ __forceinline__ void tile_v_finish(LAS unsigned char* wl, int lane, const VPend& pend) {
    const int lq = lane >> 4, c = (lane & 15) * 8;
    LAS unsigned char* const vdst = wl + (c >> 5) * 512 + (lq * 32 + (c & 31)) * 2;
#pragma unroll
    for (int j = V_FIRST; j < 16; ++j) *(LAS v4u*)(vdst + ((j & 1) + 2 * (j >> 2)) * 2048 + ((j >> 1) & 1) * 256) = pend.vv[j - V_FIRST];
}
__device__ __forceinline__ void strip_q_issue(const bf16* P, int qrow0, int qstride, int qcol, int lane, v4u (&qw)[8]) {
    const unsigned qoff = (unsigned)((lane >> 4) * qstride) * INW + qcol + (lane & 15) * 8;
#pragma unroll
    for (int j = 0; j < 8; ++j) { const bf16* rowp = P + (size_t)(qrow0 + 4 * j * qstride) * INW; qw[j] = *(const v4u*)(rowp + qoff); }
}
__device__ __forceinline__ void strip_q_none(v4u (&qw)[8]) {
#pragma unroll
    for (int j = 0; j < 8; ++j) qw[j] = (v4u){0u, 0u, 0u, 0u};
}
__device__ __forceinline__ void strip_q_finish(LAS unsigned char* wl, int lane, const v4u (&qw)[8], bf16x8 (&qr)[8]) {
    const int r32 = lane & 31, hi = lane >> 5, lq = lane >> 4;
    { LAS unsigned char* const qdst = wl + lq * 272 + (lane & 15) * 16;
#pragma unroll
      for (int j = 0; j < 8; ++j) *(LAS v4u*)(qdst + j * 4 * 272) = qw[j]; }
    LDS_WAIT(); asm volatile("" ::: "memory");
    { const LAS unsigned char* const qsrc = wl + r32 * 272 + hi * 16;
#pragma unroll
      for (int d0 = 0; d0 < 8; ++d0) qr[d0] = *(const LAS bf16x8*)(qsrc + d0 * 32); }
    LDS_WAIT(); asm volatile("" ::: "memory");
}
__device__ __forceinline__ void strip_o_store(bf16* O, int orow0, int ostride, int ldo, int ocol, LAS unsigned char* wl, int lane) {
    const int lq = lane >> 4;
    LDS_WAIT(); asm volatile("" ::: "memory");
    v4u ow[8];
    { const LAS unsigned char* const osrc = wl + lq * 272 + (lane & 15) * 16;
#pragma unroll
      for (int j = 0; j < 8; ++j) ow[j] = *(const LAS v4u*)(osrc + j * 4 * 272); }
    LDS_WAIT(); asm volatile("" ::: "memory");
    const unsigned ooff = (unsigned)(lq * ostride) * ldo + ocol + (lane & 15) * 8;
#pragma unroll
    for (int j = 0; j < 8; ++j) { bf16* rowp = O + (size_t)(orow0 + 4 * j * ostride) * ldo; *(v4u*)(rowp + ooff) = ow[j]; }
}
constexpr float SB_STOP = 1e-37f;
__device__ __forceinline__ void sb_strip(const bf16* P, bf16* OSB, int h, int t0, LAS unsigned char* wl, int lane_, v4u (&qw)[8], bool has_next, int nq_row0, int nq_stride, int nq_col) {
    int lane = lane_; asm volatile("" : "+v"(lane));
    const int r32 = lane & 31, hi = lane >> 5;
    bf16x8 qr[8];
    strip_q_finish(wl, lane, qw, qr);
    f32x16 o[4] = {}; float R = 1.f;
    const int vb = (int)(uintptr_t)wl + v_rd_base(lane);
    const int tq = t0 + r32;
    for (int jt = t0 >> 6; jt >= 0; --jt) {
        const int kb = jt * 64;
        f32x16 p0, p1;
        VPend pend; tile_qk(P, kb, 1, C_KSB + h * HD, C_VSB + h * HD, qr, wl, lane, p0, p1, pend);
#pragma unroll
        for (int r = 0; r < 16; ++r) {
            { const float z = fminf(fmaxf(p0[r] * ATT_SCALE, -80.f), 80.f), q = __builtin_amdgcn_rcpf(1.0f + __expf(z)); p0[r] = (kb + crow(r, hi) < tq) ? q : 1.0f; }
            { const float z = fminf(fmaxf(p1[r] * ATT_SCALE, -80.f), 80.f), q = __builtin_amdgcn_rcpf(1.0f + __expf(z)); p1[r] = (kb + 32 + crow(r, hi) < tq) ? q : 1.0f; }
        }
        float G0[4], G1[4], Q0[4], Q1[4];
#pragma unroll
        for (int q = 0; q < 4; ++q) { G0[q] = (p0[4 * q] * p0[4 * q + 1]) * (p0[4 * q + 2] * p0[4 * q + 3]); G1[q] = (p1[4 * q] * p1[4 * q + 1]) * (p1[4 * q + 2] * p1[4 * q + 3]);
            Q0[q] = __shfl_xor(G0[q], 32); Q1[q] = __shfl_xor(G1[q], 32); }
        float run = 1.f, S0[4], S1[4];
#pragma unroll
        for (int q = 3; q >= 0; --q) { S1[q] = hi == 0 ? run * Q1[q] : run; run *= G1[q] * Q1[q]; }
#pragma unroll
        for (int q = 3; q >= 0; --q) { S0[q] = hi == 0 ? run * Q0[q] : run; run *= G0[q] * Q0[q]; }
#pragma unroll
        for (int q = 0; q < 4; ++q) {
            float e1 = R * S1[q], e0 = R * S0[q];
#pragma unroll
            for (int i = 3; i >= 0; --i) { const int r = 4 * q + i;
                { const float qq = p1[r]; p1[r] = (1.0f - qq) * e1; e1 *= qq; }
                { const float qq = p0[r]; p0[r] = (1.0f - qq) * e0; e0 *= qq; } }
        }
        R *= run;
        tile_v_finish(wl, lane, pend);
        bf16x8 pa0, pa1, pa2, pa3; pack_p(p0, p1, pa0, pa1, pa2, pa3);
        pv_one<0>(o[0], vb, pa0, pa1, pa2, pa3); pv_one<1>(o[1], vb, pa0, pa1, pa2, pa3); pv_one<2>(o[2], vb, pa0, pa1, pa2, pa3); pv_one<3>(o[3], vb, pa0, pa1, pa2, pa3);
        if (__all(R < SB_STOP)) break;
    }
    if (has_next) strip_q_issue(P, nq_row0, nq_stride, nq_col, lane, qw); else strip_q_none(qw);
    asm volatile("" ::: "memory");
    asm volatile("s_nop 15\n\ts_nop 15" : "+v"(o[0]), "+v"(o[1]), "+v"(o[2]), "+v"(o[3]));
    { LAS unsigned char* const odst = wl + (4 * hi) * 272 + r32 * 2;
#pragma unroll
      for (int r = 0; r < 16; ++r)
#pragma unroll
        for (int d0 = 0; d0 < 4; ++d0) *(LAS bf16*)(odst + ((r & 3) + 8 * (r >> 2)) * 272 + d0 * 64) = (bf16)(pk2(o[d0][r], 0.f) & 0xffffu); }
    strip_o_store(OSB, t0, 1, SBW, h * HD, wl, lane);
}
__device__ __forceinline__ void dl_strip(const bf16* P, bf16* OB, float* ST, int h, int d, int rr, int i0, LAS unsigned char* wl, int lane_, v4u (&qw)[8], bool has_next, int nq_row0, int nq_stride, int nq_col) {
    int lane = lane_; asm volatile("" : "+v"(lane));
    const int r32 = lane & 31, hi = lane >> 5;
    bf16x8 qr[8];
    strip_q_finish(wl, lane, qw, qr);
    f32x16 o[4] = {}; float m = -1e30f, l = 0.f;
    const int vb = (int)(uintptr_t)wl + v_rd_base(lane);
    LAS float* al_l = (LAS float*)(wl + 17408);
    const int iq = i0 + r32;
    const int jlo = i0 >= 128 ? (i0 - 128) >> 6 : 0, jhi = (i0 + 31) >> 6;
    for (int jt = jlo; jt <= jhi; ++jt) {
        const int kb = jt * 64;
        f32x16 p0, p1;
        VPend pend; tile_qk(P, kb * d + rr, d, C_KDL + h * HD, C_VDL + h * HD, qr, wl, lane, p0, p1, pend);
        constexpr float C2 = ATT_SCALE * 1.4426950408889634f;
        float tmax = -3e38f;
#pragma unroll
        for (int r = 0; r < 16; ++r) {
            { const unsigned rel = (unsigned)(iq - (kb + crow(r, hi))); p0[r] = rel <= 128u ? p0[r] : -3e38f; tmax = fmaxf(tmax, p0[r]); }
            { const unsigned rel = (unsigned)(iq - (kb + 32 + crow(r, hi))); p1[r] = rel <= 128u ? p1[r] : -3e38f; tmax = fmaxf(tmax, p1[r]); }
        }
        tmax = fmaxf(tmax, __shfl_xor(tmax, 32));
        const float mn = fmaxf(m, tmax), alpha = __builtin_amdgcn_exp2f((m - mn) * C2), mnc = -mn * C2;
        float ps = 0.f;
#pragma unroll
        for (int r = 0; r < 16; ++r) { p0[r] = __builtin_amdgcn_exp2f(fmaf(p0[r], C2, mnc)); p1[r] = __builtin_amdgcn_exp2f(fmaf(p1[r], C2, mnc)); ps += p0[r] + p1[r]; }
        ps += __shfl_xor(ps, 32);
        l = l * alpha + ps; m = mn;
        if (jt > jlo && __any(alpha < 1.f)) { if (hi == 0) al_l[r32] = alpha; LDS_WAIT();
#pragma unroll
            for (int r = 0; r < 16; ++r) { const float a = al_l[crow(r, hi)];
#pragma unroll
                for (int d0 = 0; d0 < 4; ++d0) o[d0][r] *= a; }
            LDS_WAIT(); }
        tile_v_finish(wl, lane, pend);
        bf16x8 pa0, pa1, pa2, pa3; pack_p(p0, p1, pa0, pa1, pa2, pa3);
        pv_one<0>(o[0], vb, pa0, pa1, pa2, pa3); pv_one<1>(o[1], vb, pa0, pa1, pa2, pa3); pv_one<2>(o[2], vb, pa0, pa1, pa2, pa3); pv_one<3>(o[3], vb, pa0, pa1, pa2, pa3);
    }
    if (has_next) strip_q_issue(P, nq_row0, nq_stride, nq_col, lane, qw); else strip_q_none(qw);
    asm volatile("" ::: "memory");
    if (hi == 0) { al_l[r32] = l; *(f32x2*)(ST + ((size_t)(iq * d + rr) * NDLH + h) * 2) = (f32x2){m * ATT_SCALE, l}; }
    LDS_WAIT();
    { LAS unsigned char* const odst = wl + (4 * hi) * 272 + r32 * 2;
#pragma unroll
      for (int r = 0; r < 16; ++r) { const float rl = 1.0f / al_l[crow(r, hi)];
#pragma unroll
        for (int d0 = 0; d0 < 4; ++d0) *(LAS bf16*)(odst + ((r & 3) + 8 * (r >> 2)) * 272 + d0 * 64) = (bf16)(pk2(o[d0][r] * rl, 0.f) & 0xffffu); } }
    strip_o_store(OB, i0 * d + rr, d, DLW, h * HD, wl, lane);
    LDS_WAIT();
}
__device__ __forceinline__ void seg_norm_dl(const bf16* OB, const float* ST, int t, const float* gain, bf16* dst, int lane_) {
    int lane = lane_; asm volatile("" : "+v"(lane));
    float v[3][8]; float ss = 0.f;
#pragma unroll
    for (int i = 0; i < 3; ++i) { const int hd = 4 * i + (lane >> 4);
        f32x2 st[3]; float mx = -1e30f;
#pragma unroll
        for (int b = 0; b < 3; ++b) { st[b] = *(const f32x2*)(ST + (((size_t)b * SEQ + t) * NDLH + hd) * 2); mx = fmaxf(mx, st[b].x); }
        float w[3], den = 0.f;
#pragma unroll
        for (int b = 0; b < 3; ++b) { w[b] = __expf(st[b].x - mx) * st[b].y; den += w[b]; }
        const float rden = 1.0f / den;
#pragma unroll
        for (int e = 0; e < 8; ++e) v[i][e] = 0.f;
#pragma unroll
        for (int b = 0; b < 3; ++b) { const v4u a = *(const v4u*)(OB + ((size_t)b * SEQ + t) * DLW + 8 * lane + 512 * i); const float wb = w[b] * rden;
            v[i][0] += wb * bflo(a.x); v[i][1] += wb * bfhi(a.x); v[i][2] += wb * bflo(a.y); v[i][3] += wb * bfhi(a.y);
            v[i][4] += wb * bflo(a.z); v[i][5] += wb * bfhi(a.z); v[i][6] += wb * bflo(a.w); v[i][7] += wb * bfhi(a.w); }
#pragma unroll
        for (int e = 0; e < 8; ++e) ss += v[i][e] * v[i][e];
    }
    const float r = 1.0f / sqrtf(wave_sum(ss) * (1.0f / DLW) + RMS_EPS);
#pragma unroll
    for (int i = 0; i < 3; ++i) { const f32x4 g0 = *(const f32x4*)(gain + 8 * lane + 512 * i), g1 = *(const f32x4*)(gain + 8 * lane + 512 * i + 4);
        v4u o; o.x = pk2(v[i][0] * r * g0.x, v[i][1] * r * g0.y); o.y = pk2(v[i][2] * r * g0.z, v[i][3] * r * g0.w);
        o.z = pk2(v[i][4] * r * g1.x, v[i][5] * r * g1.y); o.w = pk2(v[i][6] * r * g1.z, v[i][7] * r * g1.w);
        *(v4u*)(dst + 8 * lane + 512 * i) = o; }
}


__device__ __forceinline__ void gains3_to_lds(const float* g_sb, const float* g_dl, const float* g_ssm, LAS float* gl, int lane_, int wid) {
    int lane = lane_; asm volatile("" : "+v"(lane));
    __syncthreads();
#pragma unroll
    for (int q = 0; q < 2; ++q) { const int i = (q * NWAVES + wid) * 64 + lane;
        const f32x4 v = i < 384 ? ((const f32x4*)g_sb)[i] : (i < 768 ? ((const f32x4*)g_dl)[i - 384] : ((const f32x4*)g_ssm)[i - 768]);
        ((LAS f32x4*)gl)[i] = v; }
    LDS_WAIT();
    __syncthreads();
}
__device__ __forceinline__ float ssq8(const v4u& a) {
    return (bflo(a.x) * bflo(a.x) + bfhi(a.x) * bfhi(a.x)) + (bflo(a.y) * bflo(a.y) + bfhi(a.y) * bfhi(a.y)) + (bflo(a.z) * bflo(a.z) + bfhi(a.z) * bfhi(a.z)) + (bflo(a.w) * bflo(a.w) + bfhi(a.w) * bfhi(a.w));
}
__device__ __forceinline__ v4u scale8(const v4u& a, float r, const f32x4& g0, const f32x4& g1) {
    v4u o; o.x = pk2(bflo(a.x) * r * g0.x, bfhi(a.x) * r * g0.y); o.y = pk2(bflo(a.y) * r * g0.z, bfhi(a.y) * r * g0.w);
    o.z = pk2(bflo(a.z) * r * g1.x, bfhi(a.z) * r * g1.y); o.w = pk2(bflo(a.w) * r * g1.z, bfhi(a.w) * r * g1.w); return o;
}
template <bool AB, bool SSM>
__device__ __forceinline__ void mix_row(const bf16* OSBp, const bf16* ODLp, const float* ST, const bf16* OSSMp, int t, const LAS float* gl, bf16* MIXp, int lane_) {
    int lane = lane_; asm volatile("" : "+v"(lane));
    v4u a_sb[3], a_dl[3][3], a_ss[2]; f32x2 st[3][3];
    if (AB) {
#pragma unroll
        for (int i = 0; i < 3; ++i) a_sb[i] = *(const v4u*)(OSBp + (size_t)t * SBW + 8 * lane + 512 * i);
#pragma unroll
        for (int i = 0; i < 3; ++i) { const int hd = 4 * i + (lane >> 4);
#pragma unroll
            for (int b = 0; b < 3; ++b) { st[i][b] = *(const f32x2*)(ST + (((size_t)b * SEQ + t) * NDLH + hd) * 2); a_dl[i][b] = *(const v4u*)(ODLp + ((size_t)b * SEQ + t) * DLW + 8 * lane + 512 * i); } }
    }
    if (SSM) {
#pragma unroll
        for (int i = 0; i < 2; ++i) a_ss[i] = *(const v4u*)(OSSMp + (size_t)t * SSMC + 8 * lane + 512 * i);
    }
    asm volatile("" ::: "memory");
    bf16* dst = MIXp + (size_t)t * DM;
    if (AB) {
        {
            float ss = 0.f;
#pragma unroll
            for (int i = 0; i < 3; ++i) ss += ssq8(a_sb[i]);
            const float r = 1.0f / sqrtf(wave_sum(ss) * (1.0f / SBW) + RMS_EPS);
#pragma unroll
            for (int i = 0; i < 3; ++i) { const f32x4 g0 = *(const LAS f32x4*)(gl + 8 * lane + 512 * i), g1 = *(const LAS f32x4*)(gl + 8 * lane + 512 * i + 4);
                *(v4u*)(dst + 8 * lane + 512 * i) = scale8(a_sb[i], r, g0, g1); }
        }
        {
            float v[3][8]; float ss = 0.f;
#pragma unroll
            for (int i = 0; i < 3; ++i) {
                float mx = -1e30f;
#pragma unroll
                for (int b = 0; b < 3; ++b) mx = fmaxf(mx, st[i][b].x);
                float w[3], den = 0.f;
#pragma unroll
                for (int b = 0; b < 3; ++b) { w[b] = __expf(st[i][b].x - mx) * st[i][b].y; den += w[b]; }
                const float rden = 1.0f / den;
#pragma unroll
                for (int e = 0; e < 8; ++e) v[i][e] = 0.f;
#pragma unroll
                for (int b = 0; b < 3; ++b) { const v4u a = a_dl[i][b]; const float wb = w[b] * rden;
                    v[i][0] += wb * bflo(a.x); v[i][1] += wb * bfhi(a.x); v[i][2] += wb * bflo(a.y); v[i][3] += wb * bfhi(a.y);
                    v[i][4] += wb * bflo(a.z); v[i][5] += wb * bfhi(a.z); v[i][6] += wb * bflo(a.w); v[i][7] += wb * bfhi(a.w); }
#pragma unroll
                for (int e = 0; e < 8; ++e) ss += v[i][e] * v[i][e];
            }
            const float r = 1.0f / sqrtf(wave_sum(ss) * (1.0f / DLW) + RMS_EPS);
#pragma unroll
            for (int i = 0; i < 3; ++i) { const f32x4 g0 = *(const LAS f32x4*)(gl + SBW + 8 * lane + 512 * i), g1 = *(const LAS f32x4*)(gl + SBW + 8 * lane + 512 * i + 4);
                v4u o; o.x = pk2(v[i][0] * r * g0.x, v[i][1] * r * g0.y); o.y = pk2(v[i][2] * r * g0.z, v[i][3] * r * g0.w);
                o.z = pk2(v[i][4] * r * g1.x, v[i][5] * r * g1.y); o.w = pk2(v[i][6] * r * g1.z, v[i][7] * r * g1.w);
                *(v4u*)(dst + SBW + 8 * lane + 512 * i) = o; }
        }
    }
    if (SSM) {
        float ss = 0.f;
#pragma unroll
        for (int i = 0; i < 2; ++i) ss += ssq8(a_ss[i]);
        const float r = 1.0f / sqrtf(wave_sum(ss) * (1.0f / SSMC) + RMS_EPS);
#pragma unroll
        for (int i = 0; i < 2; ++i) { const f32x4 g0 = *(const LAS f32x4*)(gl + SBW + DLW + 8 * lane + 512 * i), g1 = *(const LAS f32x4*)(gl + SBW + DLW + 8 * lane + 512 * i + 4);
            *(v4u*)(dst + SBW + DLW + 8 * lane + 512 * i) = scale8(a_ss[i], r, g0, g1); }
    }
}

struct Args { const float* in[23]; float* out; unsigned char* ws; int s_lo, s_hi; };

constexpr int I_IN = 64 * 160, I_GLU = 16 * 16, I_OUT = 64 * 64, I_G = 64 * 172, I_D = 172 * 64, I_L = I_IN + I_GLU + I_OUT + 2 * I_G + I_D;
__device__ __forceinline__ ConvItem conv_decode(const Args& args, unsigned char* ws, int item) {
    const int l = item / I_L; int r = item % I_L; ConvItem c;
    unsigned char* const WL = ws + WS_W + (size_t)l * WL_BYTES;
    if (r < I_IN) { c.W = args.in[5] + (size_t)l * DM * INW; c.K = DM; c.N = INW; c.WT = (bf16*)(WL + WO_IN); c.k0 = 64 * (r / 160); c.n0 = 64 * (r % 160); c.orow0 = c.n0; return c; } r -= I_IN;
    if (r < I_GLU) { c.W = args.in[17] + (size_t)l * SSMC * SSMC; c.K = SSMC; c.N = SSMC; c.WT = (bf16*)(WL + WO_GLU); c.k0 = 64 * (r / 16); c.n0 = 64 * (r % 16); c.orow0 = c.n0; return c; } r -= I_GLU;
    if (r < I_OUT) { c.W = args.in[19] + (size_t)l * DM * DM; c.K = DM; c.N = DM; c.WT = (bf16*)(WL + WO_OUT); c.k0 = 64 * (r / 64); c.n0 = 64 * (r % 64); c.orow0 = c.n0; return c; } r -= I_OUT;
    if (r < 2 * I_G) { const int up = r >= I_G; if (up) r -= I_G; c.W = args.in[up ? 21 : 20] + (size_t)l * DM * FFN; c.K = DM; c.N = FFN; c.WT = (bf16*)(WL + WO_GU); c.k0 = 64 * (r / 172); c.n0 = 64 * (r % 172);
        c.orow0 = 256 * (c.n0 / 128) + (c.n0 % 128) + (up ? 128 : 0); return c; } r -= 2 * I_G;
    c.W = args.in[22] + (size_t)l * FFN * DM; c.K = FFN; c.N = DM; c.WT = (bf16*)(WL + WO_DN); c.k0 = 64 * (r / 64); c.n0 = 64 * (r % 64); c.orow0 = c.n0; return c;
}
__device__ __forceinline__ void conv_item(const Args& args, unsigned char* ws, int l, int r, LAS float* scr, int lane) {
    bf16* const WL = (bf16*)(ws + WS_W + (size_t)l * WL_BYTES);
    if (r < I_IN) { tr_tile(args.in[5] + (size_t)l * DM * INW, DM, INW, (bf16*)((unsigned char*)WL + WO_IN), 64 * (r / 160), 64 * (r % 160), 64 * (r % 160), scr, lane); return; } r -= I_IN;
    if (r < I_GLU) { tr_tile(args.in[17] + (size_t)l * SSMC * SSMC, SSMC, SSMC, (bf16*)((unsigned char*)WL + WO_GLU), 64 * (r / 16), 64 * (r % 16), 64 * (r % 16), scr, lane); return; } r -= I_GLU;
    if (r < I_OUT) { tr_tile(args.in[19] + (size_t)l * DM * DM, DM, DM, (bf16*)((unsigned char*)WL + WO_OUT), 64 * (r / 64), 64 * (r % 64), 64 * (r % 64), scr, lane); return; } r -= I_OUT;
    if (r < 2 * I_G) { const int up = r >= I_G; if (up) r -= I_G; const int n0 = 64 * (r % 172);
        tr_tile(args.in[up ? 21 : 20] + (size_t)l * DM * FFN, DM, FFN, (bf16*)((unsigned char*)WL + WO_GU), 64 * (r / 172), n0, 256 * (n0 / 128) + (n0 % 128) + (up ? 128 : 0), scr, lane); return; } r -= 2 * I_G;
    tr_tile(args.in[22] + (size_t)l * FFN * DM, FFN, DM, (bf16*)((unsigned char*)WL + WO_DN), 64 * (r / 64), 64 * (r % 64), 64 * (r % 64), scr, lane);
}
__global__ void __launch_bounds__(NWAVES * 64, 2) hybrid_fwd(Args args) {
    extern __shared__ __attribute__((aligned(16))) unsigned char lds_raw[];
    LAS unsigned char* const lds = (LAS unsigned char*)lds_raw;
    volatile LAS unsigned* const MISC = (volatile LAS unsigned*)(lds + MISC_OFF);
    const int wave = __builtin_amdgcn_readfirstlane((int)threadIdx.x >> 6);
    const int G = gridDim.x, gw = blockIdx.x * NWAVES + wave, ngw = G * NWAVES;
    unsigned char* const ws = args.ws;
    gu32* const ctl = (gu32*)(ws + WS_CTL);
    LAS unsigned char* const wl = lds + wave * WAVE_LDS;
    for (int u = threadIdx.x; u < (LDS_BYTES - LDSCTL_OFF) / 4; u += NWAVES * 64) ((LAS unsigned*)(lds + LDSCTL_OFF))[u] = 0u;
    __syncthreads();
    const int s_lo = args.s_lo, s_hi = args.s_hi;
    XcdBarrier bar; bar.bar = (unsigned*)(ctl + CW_BAR); bar.x = 0; bar.st = nullptr; bar.w = wave;
    if (s_hi - s_lo > 1) bar = xcd_barrier_post((unsigned*)(ctl + CW_BAR), MISC + 8, wave);
#ifndef ROW_PF6
#define ROW_PF6 true
#endif
#ifndef ROW_PF9A
#define ROW_PF9A true
#endif
#ifndef ROW_PF9B
#define ROW_PF9B false
#endif
#ifndef ROW_PF0
#define ROW_PF0 false
#endif
#ifndef RES_F32
#define RES_F32 0
#endif
#ifndef STEP_MASK
#define STEP_MASK 0x7ff
#endif
#define EN(k) (((STEP_MASK) >> (k)) & 1)
#ifndef REP_MASK
#define REP_MASK 0
#endif
#define NREP(k) ((((REP_MASK) >> (k)) & 1) ? 2 : 1)
#ifndef MIX_NAIVE
#define MIX_NAIVE 0
#endif
#ifndef PROBE_P0
#define PROBE_P0 1
#endif
#ifndef PROBE_GU
#define PROBE_GU 0
#endif
#ifndef PROBE_S2
#define PROBE_S2 1
#endif
#ifndef PROBE_TD
#define PROBE_TD 1
#endif
#ifndef PROBE_TF
#define PROBE_TF 1
#endif
#ifndef EXP_DELAY
#define EXP_DELAY 0
#endif
#ifndef CONV_DEFER
#define CONV_DEFER 0
#endif
#ifndef CONV_PER_UNIT
#define CONV_PER_UNIT 6
#endif
#ifndef PROBE_GEMM
#define PROBE_GEMM 0
#endif
#ifndef TD_EARLY
#define TD_EARLY 8192
#endif
#ifndef CONV_PIPE
#define CONV_PIPE 1
#endif
#ifndef XN_PF
#define XN_PF true
#endif
#ifndef STAMP_MODE
#define STAMP_MODE 0
#endif
#ifndef STAMP_SUB
#define STAMP_SUB 0
#endif
#ifndef STAMP_GAIN
#define STAMP_GAIN 4
#endif
#ifndef STAMP_MASK
#define STAMP_MASK 0
#endif
#ifndef CONV_REVERSE
#define CONV_REVERSE 0
#endif
#ifndef MIX_STAGGER
#define MIX_STAGGER 0
#endif
#ifndef MIX_ITEMS
#define MIX_ITEMS 0
#endif
#ifndef TAIL_ITEMS
#define TAIL_ITEMS 0
#endif
#ifndef PROBE_SB
#define PROBE_SB 1
#endif
#ifndef PROBE_DL
#define PROBE_DL 1
#endif
#ifndef PROBE_S1
#define PROBE_S1 1
#endif
#define RUN(s) (s_lo <= (s) && (s) < s_hi)
#ifndef PROBE_BAR
#define PROBE_BAR 1
#endif
#if STAMP_MODE
    unsigned long long st_prev = wall_clock64(), st_acc = 0ull;
#define SEAM(s) do { if (RUN(s) && RUN((s) + 1)) { const unsigned long long ta_ = wall_clock64(); xcd_barrier(bar); const unsigned long long te_ = wall_clock64(); \
        if (STAMP_MODE < 3 && (((STAMP_MASK) >> (s)) & 1)) st_acc += te_ - (STAMP_MODE == 2 ? ta_ : st_prev); st_prev = te_; } } while (0)
#else
#define SEAM(s) do { if (RUN(s) && RUN((s) + 1)) { xcd_barrier(bar); if (PROBE_BAR > 1) xcd_barrier(bar); } } while (0)
#endif

    const float* const x_in = args.in[0];
    bf16* const XN = (bf16*)(ws + WS_XN); bf16* const PROJ = (bf16*)(ws + WS_PROJ); bf16* const OSB = (bf16*)(ws + WS_OSB); bf16* const HB = (bf16*)(ws + WS_H);
    bf16* const MIX = (bf16*)(ws + WS_MIX); bf16* const FB = (bf16*)(ws + WS_F);
#if RES_F32
    typedef float res_t; res_t* const X1 = (res_t*)(ws + WS_X1); res_t* const XL = args.out;
#else
    typedef bf16 res_t; res_t* const X1 = (res_t*)(ws + WS_X1); res_t* const XL = (res_t*)(ws + WS_X1 + 64 * MiB);
#endif
    bf16* const ODL = (bf16*)(ws + WS_ODL);
    bf16* const GB = (bf16*)(ws + WS_G); bf16* const OSSM = (bf16*)(ws + WS_OSSM); float* const XE = (float*)(ws + WS_XE); float* const STAT = (float*)(ws + WS_STAT);

    if (EN(0) && RUN(0)) { const int ln = fresh_lane();
        LAS float* scr = (LAS float*)wl;
#if STAMP_MODE == 5
        const unsigned long long tp0_ = wall_clock64();
#endif
        const int ntail = (G == 256) ? TAIL_ITEMS + MIX_ITEMS : 0;
        const int nconv = DEPTH * I_L - ntail;
#define CONV_MAP(i) (CONV_REVERSE && ntail == 0 ? nconv - 1 - (i) : ((i) < I_L ? (i) : (i) + ntail))
#if CONV_PIPE
        {
            f32x4 va[16], vb[16]; int it0 = gw; const int nit = PROBE_P0 * nconv;
            ConvItem ca = conv_decode(args, ws, CONV_MAP((it0 < nit ? it0 : 0) % nconv)), cb = ca;
            if (it0 < nit) tr_load(ca, ln, va);
            while (it0 < nit) {
                const int it1 = it0 + ngw; if (it1 < nit) { cb = conv_decode(args, ws, CONV_MAP(it1 % nconv)); tr_load(cb, ln, vb); }
                tr_store(ca, scr, ln, va);
                if (it1 >= nit) break;
                const int it2 = it1 + ngw; if (it2 < nit) { ca = conv_decode(args, ws, CONV_MAP(it2 % nconv)); tr_load(ca, ln, va); }
                tr_store(cb, scr, ln, vb);
                it0 = it2;
            }
        }
#else
        for (int it0 = gw; it0 < PROBE_P0 * nconv; it0 += ngw) { const int it = CONV_MAP(it0 % nconv); conv_item(args, ws, it / I_L, it % I_L, scr, ln); }
#endif
#undef CONV_MAP
#if STAMP_MODE == 5
        asm volatile("s_waitcnt vmcnt(0)" ::: "memory"); const unsigned long long tp1_ = wall_clock64(); if (STAMP_SUB == 1) st_acc += tp1_ - tp0_;
#endif
        for (int m0 = gw; m0 < PROBE_P0 * SEQ; m0 += ngw) { const int m = m0 % SEQ; row_op(x_in + (size_t)m * DM, (const bf16*)nullptr, (const float*)nullptr, (float*)nullptr, args.in[1], XN + (size_t)m * DM, ln); }
#if STAMP_MODE == 5
        { asm volatile("s_waitcnt vmcnt(0)" ::: "memory"); const unsigned long long tp2_ = wall_clock64(); if (STAMP_SUB == 2) st_acc += tp2_ - tp1_; }
#endif
    }
    SEAM(0);

    for (int l = 0; l < DEPTH; ++l) {
        const int sb = 1 + STEPS_PER_LAYER * l;
        const unsigned char* const WL = ws + WS_W + (size_t)l * WL_BYTES;
        if (EN(1) && RUN(sb + 0)) {
            pg8::Gemm g{XN, (const bf16*)(WL + WO_IN), SEQ, INW, DM}; pg8::StaticOrder S; S.init(SEQ, INW, G, (int)blockIdx.x);
            pg8::EpiStoreBf16 E{PROJ, INW};
            pg8::gemm_phase<pg8::EpiStoreBf16, pg8::StaticOrder, true, true>(lds, g, S, E, wave);
#if PROBE_GEMM == 1 || PROBE_GEMM == 9
            pg8::gemm_phase<pg8::EpiStoreBf16, pg8::StaticOrder, true, true>(lds, g, S, E, wave);
#endif
        }
        SEAM(sb + 0);
        if (EN(2) && RUN(sb + 1)) { const int ln = fresh_lane();
            if (wave >= 4) __builtin_amdgcn_s_setprio(1);
            const int gwx = (G % 8 == 0) ? (((int)blockIdx.x % 8) * (G / 8) + (int)blockIdx.x / 8) * NWAVES + wave : gw;
            int tc = gw;
#define CONV_SOME(n) do { if (MIX_ITEMS > 0 && G == 256 && l == 0) for (int q_ = 0; q_ < (n) && tc < MIX_ITEMS; ++q_, tc += ngw) conv_item(args, ws, 1, TAIL_ITEMS + tc, (LAS float*)wl, ln); } while (0)
#if EXP_OLDSSM & 1
            SsmWOld wo{args.in[9] + l * NGRP * NST, args.in[10] + l * NGRP * NST, args.in[11] + l * NGRP, args.in[12] + (size_t)l * NGRP * NST * SGRP, args.in[13] + (size_t)l * NGRP * NST * SGRP,
                   args.in[14] + (size_t)l * NGRP * SGRP * NST, args.in[15] + (size_t)l * NGRP * SGRP * NST, args.in[16] + l * SSMC};
            for (int u = gw; u < SSM_NCH * NGRP; u += ngw) ssm_pass1_old(PROJ, wo, XE, u % NGRP, u / NGRP, wl, ln);
#else
            const SsmW w{args.in[9] + l * NGRP * NST, args.in[10] + l * NGRP * NST, args.in[11] + l * NGRP, args.in[12] + (size_t)l * NGRP * NST * SGRP, args.in[13] + (size_t)l * NGRP * NST * SGRP,
                         args.in[14] + (size_t)l * NGRP * SGRP * NST, args.in[15] + (size_t)l * NGRP * SGRP * NST, args.in[16] + l * SSMC};
#if MIX_STAGGER
#pragma clang loop unroll(disable)
            for (int ph = 0; ph < 2; ++ph) {
            if ((ph == 0) == (((wave >> 2) & 1) == 1))
#endif
#if STAMP_MODE == 3
            const unsigned long long ts0_ = wall_clock64();
#endif
            for (int u = gwx; u < PROBE_S1 * SSM_NCH * NGRP; u += ngw) { const int v = u % (SSM_NCH * NGRP); ssm_unit<false>(PROJ, w, XE, nullptr, v % NGRP, v / NGRP, wl, ln); }
#if STAMP_MODE == 3
            const unsigned long long ts1_ = wall_clock64(); if (STAMP_SUB == 1) st_acc += ts1_ - ts0_;
#endif
#if MIX_STAGGER
            else {
#endif
#endif
#if MIX_NAIVE
            for (int u = gw; u < PROBE_SB * NSBH * SEQ; u += ngw) { const int v = u % (NSBH * SEQ); sb_naive(PROJ, OSB, v / SEQ, v % SEQ, ln); }
            for (int u = gw; u < PROBE_DL * NDLH * SEQ; u += ngw) { const int v = u % (NDLH * SEQ); dl_naive(PROJ, ODL, v / SEQ, v % SEQ, ln); }
#else
            {
                constexpr int NSB_ = NSBH * 256, NDL_ = 3 * NDLH * 256;
#define DL_DESC(v_, b_, hh_, d_, rr_, i0_) const int b_ = (v_) / (NDLH * 256), hh_ = ((v_) % (NDLH * 256)) >> 8, d_ = b_ == 0 ? 1 : (b_ == 1 ? 4 : 16), rr_ = (((v_) % (NDLH * 256)) & 255) / (256 / d_), i0_ = 32 * ((((v_) % (NDLH * 256)) & 255) % (256 / d_))
                int usb = gwx, udl = ngw - 1 - gwx;
                v4u qw[8];
                if (usb < NSB_) strip_q_issue(PROJ, 32 * (usb & 255), 1, C_QSB + (usb >> 8) * HD, ln, qw);
                else if (udl < NDL_) { DL_DESC(udl, b, hh, d, rr, i0); strip_q_issue(PROJ, i0 * d + rr, d, C_QDL + hh * HD, ln, qw); }
                else strip_q_none(qw);
                for (; usb < NSB_; usb += ngw) { const int un = usb + ngw;
                    bool hn; int nr0, nst, nc;
                    if (un < NSB_) { hn = true; nr0 = 32 * (un & 255); nst = 1; nc = C_QSB + (un >> 8) * HD; }
                    else if (udl < NDL_) { DL_DESC(udl, b, hh, d, rr, i0); hn = true; nr0 = i0 * d + rr; nst = d; nc = C_QDL + hh * HD; }
                    else { hn = false; nr0 = 0; nst = 1; nc = 0; }
                    sb_strip(PROJ, OSB, usb >> 8, 32 * (usb & 255), wl, ln, qw, hn, nr0, nst, nc); }
                for (; udl < NDL_; udl += ngw) { DL_DESC(udl, b, hh, d, rr, i0); const int un = udl + ngw;
                    bool hn = un < NDL_; int nr0 = 0, nst = 1, nc = 0;
                    if (hn) { DL_DESC(un, b2, hh2, d2, rr2, i02); nr0 = i02 * d2 + rr2; nst = d2; nc = C_QDL + hh2 * HD; }
                    dl_strip(PROJ, ODL + (size_t)b * SEQ * DLW, STAT + (size_t)b * SEQ * NDLH * 2, hh, d, rr, i0, wl, ln, qw, hn, nr0, nst, nc); }
#undef DL_DESC
            }
#endif
#if MIX_STAGGER && !(EXP_OLDSSM & 1)
            } }
#endif
#undef CONV_SOME
            __builtin_amdgcn_s_setprio(0);
        }
        SEAM(sb + 1);
        if (EN(3) && RUN(sb + 2)) { const int ln = fresh_lane();
            if (wave >= 4) __builtin_amdgcn_s_setprio(1);
            const int gwx = (G % 8 == 0) ? (((int)blockIdx.x % 8) * (G / 8) + (int)blockIdx.x / 8) * NWAVES + wave : gw;
#if EXP_DELAY
            for (int i = 0; i < 40; ++i) __builtin_amdgcn_s_sleep(127);
#endif
#if EXP_OLDSSM & 2
            SsmWOld wo{args.in[9] + l * NGRP * NST, args.in[10] + l * NGRP * NST, args.in[11] + l * NGRP, args.in[12] + (size_t)l * NGRP * NST * SGRP, args.in[13] + (size_t)l * NGRP * NST * SGRP,
                   args.in[14] + (size_t)l * NGRP * SGRP * NST, args.in[15] + (size_t)l * NGRP * SGRP * NST, args.in[16] + l * SSMC};
            for (int u = gw; u < SSM_NCH * NGRP; u += ngw) ssm_pass2_old(PROJ, wo, XE, GB, u % NGRP, u / NGRP, wl, ln);
#else
            const SsmW w{args.in[9] + l * NGRP * NST, args.in[10] + l * NGRP * NST, args.in[11] + l * NGRP, args.in[12] + (size_t)l * NGRP * NST * SGRP, args.in[13] + (size_t)l * NGRP * NST * SGRP,
                         args.in[14] + (size_t)l * NGRP * SGRP * NST, args.in[15] + (size_t)l * NGRP * SGRP * NST, args.in[16] + l * SSMC};
            for (int u = gwx; u < PROBE_S2 * SSM_NCH * NGRP; u += ngw) { const int v = u % (SSM_NCH * NGRP), c = v / NGRP;
                ssm_unit<true>(PROJ, w, XE, GB, v % NGRP, c < SSM_NCH / 2 ? c : 3 * SSM_NCH / 2 - 1 - c, wl, ln); }
#endif
            __builtin_amdgcn_s_setprio(0);
        }
        SEAM(sb + 2);
        if (EN(4) && RUN(sb + 3)) {
#if EXP_DELAY
            for (int i = 0; i < 40; ++i) __builtin_amdgcn_s_sleep(127);
#endif
            pg8::Gemm g{GB, (const bf16*)(WL + WO_GLU), SEQ, SSMC, SSMC}; pg8::StaticOrder S; S.init(SEQ, SSMC, G, (int)blockIdx.x);
            pg8::EpiGlu E{GB, OSSM, SSMC, args.in[18] + l * SSMC};
            pg8::gemm_phase<pg8::EpiGlu, pg8::StaticOrder, true, true>(lds, g, S, E, wave);
            const int nun = (SEQ / 256) * (SSMC / 256);
            if ((int)blockIdx.x >= nun && G > nun) { const int ln = fresh_lane(); const int gw2 = ((int)blockIdx.x - nun) * NWAVES + wave, ngw2 = (G - nun) * NWAVES;
                gains3_to_lds(args.in[6] + l * SBW, args.in[7] + l * DLW, args.in[8] + l * SSMC, (LAS float*)lds, ln, wave);
                for (int t = gw2; t < TD_EARLY; t += ngw2) mix_row<true, false>(OSB, ODL, STAT, OSSM, t, (const LAS float*)lds, MIX, ln); }
        }
        SEAM(sb + 3);
        if (EN(5) && RUN(sb + 4)) { const int ln = fresh_lane();
            const int t_early = (G > (SEQ / 256) * (SSMC / 256)) ? TD_EARLY : 0;
            gains3_to_lds(args.in[6] + l * SBW, args.in[7] + l * DLW, args.in[8] + l * SSMC, (LAS float*)lds, ln, wave);
            for (int t0 = gw; t0 < PROBE_TD * SEQ; t0 += ngw) { const int t = t0 % SEQ;
                if (t >= t_early) mix_row<true, true>(OSB, ODL, STAT, OSSM, t, (const LAS float*)lds, MIX, ln);
                else mix_row<false, true>(OSB, ODL, STAT, OSSM, t, (const LAS float*)lds, MIX, ln);
            }
        }
        SEAM(sb + 4);
        if (EN(6) && RUN(sb + 5)) {
            pg8::Gemm g{MIX, (const bf16*)(WL + WO_OUT), SEQ, DM, DM}; pg8::StaticOrder S; S.init(SEQ, DM, G, (int)blockIdx.x);
            pg8::EpiStoreBf16 E{FB, DM};
            pg8::gemm_phase<pg8::EpiStoreBf16, pg8::StaticOrder, true, true>(lds, g, S, E, wave);
#if PROBE_GEMM == 2 || PROBE_GEMM == 9
            pg8::gemm_phase<pg8::EpiStoreBf16, pg8::StaticOrder, true, true>(lds, g, S, E, wave);
#endif
        }
        SEAM(sb + 5);
        if (EN(7) && RUN(sb + 6)) { const int ln = fresh_lane();
            gains_to_lds(args.in[2] + l * DM, args.in[3] + l * DM, (LAS float*)lds, ln, wave);
            if (l == 0) row_phase<float, res_t, true, ROW_PF0>(x_in, FB, (const LAS float*)lds, X1, XN, gw, ngw, PROBE_TF * SEQ, ln);
            else row_phase<res_t, res_t, true, ROW_PF6>(XL, FB, (const LAS float*)lds, X1, XN, gw, ngw, PROBE_TF * SEQ, ln);
        }
        SEAM(sb + 6);
        if (EN(8) && RUN(sb + 7)) {
            pg8::Gemm g{XN, (const bf16*)(WL + WO_GU), SEQ, GUW, DM}; pg8::StaticOrder S; S.init(SEQ, GUW, G, (int)blockIdx.x);
            pg8::EpiSwiGLU E{HB, FFN};
            pg8::gemm_phase<pg8::EpiSwiGLU, pg8::StaticOrder, true, true>(lds, g, S, E, wave);
            if (l == 0 && G == 256 && (int)blockIdx.x >= 192) { const int ln = fresh_lane(); const int gw2 = ((int)blockIdx.x - 192) * NWAVES + wave;
                for (int it = gw2; it < TAIL_ITEMS; it += 64 * NWAVES) conv_item(args, ws, 1, it, (LAS float*)wl, ln); }
#if PROBE_GU || PROBE_GEMM == 9
            pg8::gemm_phase<pg8::EpiSwiGLU, pg8::StaticOrder, true, true>(lds, g, S, E, wave);
#endif
        }
        SEAM(sb + 7);
        if (EN(9) && RUN(sb + 8)) {
            pg8::Gemm g{HB, (const bf16*)(WL + WO_DN), SEQ, DM, FFN}; pg8::StaticOrder S; S.init(SEQ, DM, G, (int)blockIdx.x);
            pg8::EpiStoreBf16 E{FB, DM};
            pg8::gemm_phase<pg8::EpiStoreBf16, pg8::StaticOrder, true, true>(lds, g, S, E, wave);
#if PROBE_GEMM == 3 || PROBE_GEMM == 9
            pg8::gemm_phase<pg8::EpiStoreBf16, pg8::StaticOrder, true, true>(lds, g, S, E, wave);
#endif
        }
        SEAM(sb + 8);
        if (EN(10) && RUN(sb + 9)) { const int ln = fresh_lane();
            const bool more = l + 1 < DEPTH;
            gains_to_lds(args.in[4] + l * DM, more ? args.in[1] + (l + 1) * DM : nullptr, (LAS float*)lds, ln, wave);
            if (more) row_phase<res_t, res_t, true, ROW_PF9A>(X1, FB, (const LAS float*)lds, XL, XN, gw, ngw, PROBE_TF * SEQ, ln);
            else row_phase<res_t, float, false, ROW_PF9B>(X1, FB, (const LAS float*)lds, args.out, (bf16*)nullptr, gw, ngw, PROBE_TF * SEQ, ln);
        }
        SEAM(sb + 9);
    }
#if STAMP_MODE
    { asm volatile("s_waitcnt vmcnt(0)" ::: "memory"); __syncthreads();
      const unsigned long long te_ = wall_clock64(); if (STAMP_MODE == 1 && (((STAMP_MASK) >> (NSTEPS - 1)) & 1)) st_acc += te_ - st_prev;
      const unsigned long long until_ = te_ + (unsigned long long)STAMP_GAIN * st_acc;
      while (wall_clock64() < until_) __builtin_amdgcn_s_sleep(64); }
#endif
#undef RUN
#undef SEAM
}

extern "C" void kernel_launch(void* const* d_in, const int* in_sizes, int n_in, void* d_out, int out_size, void* d_ws, size_t ws_size, hipStream_t stream) {
    static int grid = 0;
    if (grid == 0) {
        if (n_in != 23 || in_sizes[0] != SEQ * DM || out_size != SEQ * DM || ws_size < WS_END) { fprintf(stderr, "kernel_launch: unexpected shapes (n_in %d, in0 %d, out %d, ws %zu < %zu); nothing launched\n", n_in, n_in > 0 ? in_sizes[0] : -1, out_size, ws_size, (size_t)WS_END); grid = -1; return; }
        int dev = 0, cus = 0, per_cu = 0;
        if (hipGetDevice(&dev) != hipSuccess || hipDeviceGetAttribute(&cus, hipDeviceAttributeMultiprocessorCount, dev) != hipSuccess) { fprintf(stderr, "kernel_launch: device query failed\n"); grid = -1; return; }
        if (hipFuncSetAttribute((const void*)hybrid_fwd, hipFuncAttributeMaxDynamicSharedMemorySize, LDS_BYTES) != hipSuccess) { fprintf(stderr, "kernel_launch: hipFuncSetAttribute failed\n"); grid = -1; return; }
        if (hipOccupancyMaxActiveBlocksPerMultiprocessor(&per_cu, (const void*)hybrid_fwd, NWAVES * 64, LDS_BYTES) != hipSuccess || per_cu < 1)
            fprintf(stderr, "kernel_launch: note: occupancy query reports %d workgroups per CU\n", per_cu);
        (void)hipGetLastError();
        grid = cus;
    }
    if (grid < 0) return;
    if (hipMemsetAsync((char*)d_ws + WS_CTL, 0, CTL_ZERO_BYTES, stream) != hipSuccess) { fprintf(stderr, "kernel_launch: hipMemsetAsync failed\n"); return; }
    Args a{};
    for (int i = 0; i < 23; ++i) a.in[i] = (const float*)d_in[i];
    a.out = (float*)d_out; a.ws = (unsigned char*)d_ws;
#if MK_SINGLE
    a.s_lo = 0; a.s_hi = NSTEPS;
    hipLaunchKernelGGL(hybrid_fwd, dim3(grid), dim3(NWAVES * 64), LDS_BYTES, stream, a);
#else
    for (int s = 0; s < NSTEPS; ++s) { a.s_lo = s; a.s_hi = s + 1; hipLaunchKernelGGL(hybrid_fwd, dim3(grid), dim3(NWAVES * 64), LDS_BYTES, stream, a); }
#endif
    const hipError_t le = hipPeekAtLastError();
    if (le != hipSuccess) fprintf(stderr, "kernel_launch: launch failed: %s\n", hipGetErrorName(le));
}
```

```cpp
#include <hip/hip_runtime.h>
#include <cstdio>
#include <cstdint>
namespace pg8 {
#define PG8_LAS __attribute__((address_space(3)))
typedef unsigned short bf16_t;
typedef short bf16x8 __attribute__((ext_vector_type(8)));
typedef float f32x4 __attribute__((ext_vector_type(4)));
typedef unsigned u32x4 __attribute__((ext_vector_type(4)));
constexpr int BM = 256, BK = 64, HALF = 128, HTB = HALF * BK * 2  , STAGE_BYTES = 8 * HTB, NXCD = 8, WGM = 8;

__host__ __device__ __forceinline__ int lds_byte(int r, int c) { const int st = (r >> 4) * 2 + (c >> 5), rr = r & 15, cc = c & 31, ob = rr * 64 + cc * 2; return st * 1024 + (ob ^ (((ob >> 9) & 1) << 5)); }
__host__ __device__ __forceinline__ void stage_rc(int b, int& R, int& C) { const int st = b / 1024, sb = b % 1024, swz = sb ^ (((sb >> 9) & 1) << 5); R = (st >> 1) * 16 + swz / 64; C = (st & 1) * 32 + (swz % 64) / 2; }
__host__ __device__ __forceinline__ int perm32(int rho) { const int n = rho >> 4, i = rho & 15; return 8 * (i >> 2) + 4 * n + (i & 3); }

struct Unit { int pm, pn; };
struct Gemm { const bf16_t* A; const bf16_t* Bt; int M, N, K; };

struct StaticOrder {
    int nM, nN, nwg, G, c;
    __host__ __device__ void init(int M, int N, int G_, int c_) { nM = M / BM; nN = N / BM; nwg = nM * nN; G = G_; c = c_; }
    __host__ __device__ bool next(int i, Unit& u) const {
        const long L = (long)i * G + c; if (L >= nwg) return false;
        int wgid = (int)L; { const int q = nwg / NXCD, r = nwg % NXCD, xcd = wgid % NXCD, off = wgid / NXCD; wgid = (xcd < r ? xcd * (q + 1) : r * (q + 1) + (xcd - r) * q) + off; }
        const int nig = WGM * nN, gid = wgid / nig, fm = gid * WGM, gsz = (nM - fm) < WGM ? (nM - fm) : WGM;
        u.pm = fm + ((wgid % nig) % gsz); u.pn = (wgid % nig) / gsz; return true;
    }
    __device__ __forceinline__ void a_ready(const Unit&) const {}
    __device__ __forceinline__ void done(const Unit&) const {}
};


__device__ __forceinline__ unsigned cvt_pk_bf16(float lo, float hi) { unsigned r; asm volatile("v_cvt_pk_bf16_f32 %0, %1, %2" : "=v"(r) : "v"(lo), "v"(hi)); return r; }
__device__ __forceinline__ float bf_lo(unsigned w) { return __uint_as_float(w << 16); }
__device__ __forceinline__ float bf_hi(unsigned w) { return __uint_as_float(w & 0xffff0000u); }
__device__ __forceinline__ float fast_sigmoid(float x) { return __builtin_amdgcn_rcpf(1.0f + __builtin_amdgcn_exp2f(-1.4426950408889634f * x)); }

struct EpiStoreBf16 {
    static constexpr bool PERM = true, AFTER_DRAIN = false;
    bf16_t* O; int ldc;
    __device__ __forceinline__ void operator()(const f32x4 (&acc)[2][2][4][2], const Unit& u, int wr, int wc, int fr, int fq) const {
        const int row0 = u.pm * BM + wr * 64 + fr, col0 = u.pn * BM + wc * 32 + 8 * fq;
#pragma unroll
        for (int ai = 0; ai < 2; ++ai)
#pragma unroll
            for (int m = 0; m < 4; ++m) { bf16_t* rowp = O + (size_t)(row0 + ai * HALF + m * 16) * ldc + col0;
#pragma unroll
                for (int bj = 0; bj < 2; ++bj) { const f32x4 v0 = acc[ai][bj][m][0], v1 = acc[ai][bj][m][1];
                    u32x4 w; w.x = cvt_pk_bf16(v0[0], v0[1]); w.y = cvt_pk_bf16(v0[2], v0[3]); w.z = cvt_pk_bf16(v1[0], v1[1]); w.w = cvt_pk_bf16(v1[2], v1[3]);
                    *(u32x4*)(rowp + bj * HALF) = w; } }
    }
};
struct EpiSwiGLU {
    static constexpr bool PERM = true, AFTER_DRAIN = false;
    bf16_t* H; int ldh;
    __device__ __forceinline__ void operator()(const f32x4 (&acc)[2][2][4][2], const Unit& u, int wr, int wc, int fr, int fq) const {
        const int row0 = u.pm * BM + wr * 64 + fr, col0 = u.pn * HALF + wc * 32 + 8 * fq;
#pragma unroll
        for (int ai = 0; ai < 2; ++ai)
#pragma unroll
            for (int m = 0; m < 4; ++m) { bf16_t* rowp = H + (size_t)(row0 + ai * HALF + m * 16) * ldh + col0;
                float h[8];
#pragma unroll
                for (int n = 0; n < 2; ++n)
#pragma unroll
                    for (int e = 0; e < 4; ++e) { const float g = acc[ai][0][m][n][e], up = acc[ai][1][m][n][e]; h[4 * n + e] = g * fast_sigmoid(g) * up; }
                u32x4 w; w.x = cvt_pk_bf16(h[0], h[1]); w.y = cvt_pk_bf16(h[2], h[3]); w.z = cvt_pk_bf16(h[4], h[5]); w.w = cvt_pk_bf16(h[6], h[7]);
                *(u32x4*)rowp = w; }
    }
};
struct EpiGlu {
    static constexpr bool PERM = true, AFTER_DRAIN = false;
    const bf16_t* Gv; bf16_t* O; int ldc; const float* bias;
    __device__ __forceinline__ void operator()(const f32x4 (&acc)[2][2][4][2], const Unit& u, int wr, int wc, int fr, int fq) const {
        const int row0 = u.pm * BM + wr * 64 + fr, col0 = u.pn * BM + wc * 32 + 8 * fq;
        f32x4 bv[2][2];
#pragma unroll
        for (int bj = 0; bj < 2; ++bj)
#pragma unroll
            for (int n = 0; n < 2; ++n) bv[bj][n] = *(const f32x4*)(bias + col0 + bj * HALF + 4 * n);
#pragma unroll
        for (int ai = 0; ai < 2; ++ai) {
            u32x4 gall[4][2];
#pragma unroll
            for (int m = 0; m < 4; ++m)
#pragma unroll
                for (int bj = 0; bj < 2; ++bj) gall[m][bj] = *(const u32x4*)(Gv + (size_t)(row0 + ai * HALF + m * 16) * ldc + col0 + bj * HALF);
            asm volatile("" ::: "memory");
#pragma unroll
            for (int m = 0; m < 4; ++m) { const size_t off = (size_t)(row0 + ai * HALF + m * 16) * ldc + col0;
#pragma unroll
                for (int bj = 0; bj < 2; ++bj) { const u32x4 gw = gall[m][bj];
                    const f32x4 v0 = acc[ai][bj][m][0] + bv[bj][0], v1 = acc[ai][bj][m][1] + bv[bj][1];
                    u32x4 w;
                    w.x = cvt_pk_bf16(bf_lo(gw.x) * fast_sigmoid(v0[0]), bf_hi(gw.x) * fast_sigmoid(v0[1]));
                    w.y = cvt_pk_bf16(bf_lo(gw.y) * fast_sigmoid(v0[2]), bf_hi(gw.y) * fast_sigmoid(v0[3]));
                    w.z = cvt_pk_bf16(bf_lo(gw.z) * fast_sigmoid(v1[0]), bf_hi(gw.z) * fast_sigmoid(v1[1]));
                    w.w = cvt_pk_bf16(bf_lo(gw.w) * fast_sigmoid(v1[2]), bf_hi(gw.w) * fast_sigmoid(v1[3]));
                    *(u32x4*)(O + off + bj * HALF) = w; } }
            asm volatile("" ::: "memory"); }
    }
};

template <class Epi, class Sched, bool ALIGN_EPI = false, bool SP2 = false>
__device__ __forceinline__ void gemm_phase(PG8_LAS unsigned char* lds, const Gemm g, const Sched& S, const Epi& E, const int wid) {
    int lane_; asm volatile("v_mbcnt_lo_u32_b32 %0, -1, 0\n\tv_mbcnt_hi_u32_b32 %0, -1, %0" : "=v"(lane_));
    int wid_ = wid; asm volatile("" : "+s"(wid_));
    const int lane = lane_, tid = wid_ * 64 + lane, wr = wid_ >> 2, wc = wid_ & 3, fr = lane & 15, fq = lane >> 4;
    const int K = g.K, nt = K / BK;
    unsigned voffA[2], voffB[2];
#pragma unroll
    for (int i = 0; i < 2; ++i) { int R, C; stage_rc(tid * 16 + i * 8192, R, C); const int Rb = Epi::PERM ? ((R & ~31) + perm32(R & 31)) : R;
        voffA[i] = (unsigned)(R * K + C) * 2u; voffB[i] = (unsigned)(Rb * K + C) * 2u; }
    const size_t kstep = (size_t)(BK * 2);
    const size_t hstep = (size_t)HALF * K * 2;
    const size_t tstep = 2 * hstep;
    const unsigned ldsw = (unsigned)wid_ * 1024u;
    const int aoff = lds_byte(wr * 64 + fr, fq * 8), boff = lds_byte(wc * 32 + fr, fq * 8);
#define PG8_SA(b, h) (((b) * 2 + (h)) * HTB)
#define PG8_SB(b, h) ((4 + (b) * 2 + (h)) * HTB)
#define PG8_STAGE(bufoff, gbase, voff) do { _Pragma("unroll") for (int _i = 0; _i < 2; ++_i) \
        __builtin_amdgcn_global_load_lds((const unsigned*)((const char*)(gbase) + (voff)[_i]), (PG8_LAS unsigned*)(lds + (bufoff) + ldsw + _i * 8192), 16, 0, 0); } while (0)
#define PG8_LDA(dst, b, h) do { _Pragma("unroll") for (int m = 0; m < 4; ++m) _Pragma("unroll") for (int k = 0; k < 2; ++k) dst[m][k] = *(const PG8_LAS bf16x8*)(lds + PG8_SA(b, h) + aoff + m * 2048 + k * 1024); } while (0)
#define PG8_LDB(dst, b, h) do { _Pragma("unroll") for (int n = 0; n < 2; ++n) _Pragma("unroll") for (int k = 0; k < 2; ++k) dst[n][k] = *(const PG8_LAS bf16x8*)(lds + PG8_SB(b, h) + boff + n * 2048 + k * 1024); } while (0)
#define PG8_MMA(ai, bj, At, Bt) do { __builtin_amdgcn_s_setprio(1); _Pragma("unroll") for (int m = 0; m < 4; ++m) _Pragma("unroll") for (int n = 0; n < 2; ++n) _Pragma("unroll") for (int k = 0; k < 2; ++k) \
        acc[ai][bj][m][n] = __builtin_amdgcn_mfma_f32_16x16x32_bf16(Bt[n][k], At[m][k], acc[ai][bj][m][n], 0, 0, 0); __builtin_amdgcn_s_setprio(0); } while (0)
#define PG8_WAIT_V(n) asm volatile("s_waitcnt vmcnt(" #n ")" ::: "memory")
#define PG8_WAIT_L(n) asm volatile("s_waitcnt lgkmcnt(" #n ")" ::: "memory")
#define PG8_BAR __builtin_amdgcn_s_barrier()
#define PG8_SCHED __builtin_amdgcn_sched_barrier(0)
    Unit cur, nxt; int ui = 0;
    if (!S.next(0, cur)) return;
    f32x4 acc[2][2][4][2];
#pragma unroll
    for (int a = 0; a < 2; ++a)
#pragma unroll
        for (int b = 0; b < 2; ++b)
#pragma unroll
            for (int m = 0; m < 4; ++m)
#pragma unroll
                for (int n = 0; n < 2; ++n) acc[a][b][m][n] = (f32x4){0.f, 0.f, 0.f, 0.f};
    bf16x8 At[4][2], B0[2][2], B1[2][2];
    const char* cA = (const char*)g.A + (size_t)cur.pm * tstep; const char* cB = (const char*)g.Bt + (size_t)cur.pn * tstep;
    S.a_ready(cur);
    if constexpr (SP2) {
        PG8_STAGE(PG8_SB(0, 0), cB, voffB); PG8_STAGE(PG8_SB(0, 1), cB + hstep, voffB); PG8_STAGE(PG8_SA(0, 0), cA, voffA); PG8_STAGE(PG8_SA(0, 1), cA + hstep, voffA);
        if (wr == 1) PG8_BAR;
        PG8_WAIT_V(2); PG8_BAR;
        PG8_STAGE(PG8_SB(1, 0), cB + kstep, voffB); PG8_STAGE(PG8_SA(1, 0), cA + kstep, voffA); PG8_STAGE(PG8_SB(1, 1), cB + hstep + kstep, voffB);
        PG8_WAIT_V(6); PG8_BAR;
    } else {
        PG8_STAGE(PG8_SB(0, 0), cB, voffB); PG8_STAGE(PG8_SA(0, 0), cA, voffA); PG8_STAGE(PG8_SB(0, 1), cB + hstep, voffB); PG8_STAGE(PG8_SA(0, 1), cA + hstep, voffA);
        if (wr == 1) PG8_BAR;
        PG8_WAIT_V(4); PG8_BAR;
        PG8_STAGE(PG8_SB(1, 0), cB + kstep, voffB); PG8_STAGE(PG8_SA(1, 0), cA + kstep, voffA); PG8_STAGE(PG8_SB(1, 1), cB + hstep + kstep, voffB);
        PG8_WAIT_V(6); PG8_BAR;
    }
    for (;;) {
        const bool has_next = S.next(ui + 1, nxt);
        const char* nA = has_next ? (const char*)g.A + (size_t)nxt.pm * tstep : cA; const char* nB = has_next ? (const char*)g.Bt + (size_t)nxt.pn * tstep : cB;
        for (int t = 0; t < nt; t += 2) {
            const bool last = (t == nt - 2);
            const char* a1 = cA + (size_t)(t + 1) * kstep;
            const char* a2 = last ? nA : cA + (size_t)(t + 2) * kstep; const char* b2 = last ? nB : cB + (size_t)(t + 2) * kstep;
            const char* a3 = a2 + kstep; const char* b3 = b2 + kstep;
            if (last && has_next) S.a_ready(nxt);
            if constexpr (SP2) {
            PG8_LDB(B0, 0, 0); PG8_LDB(B1, 0, 1); PG8_SCHED; PG8_LDA(At, 0, 0); PG8_STAGE(PG8_SA(1, 1), a1 + hstep, voffA);
            PG8_WAIT_V(8); PG8_WAIT_L(0); PG8_BAR; PG8_MMA(0, 0, At, B0); PG8_MMA(0, 1, At, B1); PG8_BAR; PG8_SCHED;
            PG8_LDA(At, 0, 1); PG8_STAGE(PG8_SB(0, 0), b2, voffB); PG8_STAGE(PG8_SB(0, 1), b2 + hstep, voffB); PG8_STAGE(PG8_SA(0, 0), a2, voffA);
            PG8_WAIT_V(8); PG8_WAIT_L(0); PG8_BAR; PG8_MMA(1, 0, At, B0); PG8_MMA(1, 1, At, B1); PG8_BAR; PG8_SCHED;
            PG8_LDB(B0, 1, 0); PG8_LDB(B1, 1, 1); PG8_SCHED; PG8_LDA(At, 1, 0); PG8_STAGE(PG8_SA(0, 1), a2 + hstep, voffA);
            PG8_WAIT_V(8); PG8_WAIT_L(0); PG8_BAR; PG8_MMA(0, 0, At, B0); PG8_MMA(0, 1, At, B1); PG8_BAR; PG8_SCHED;
            PG8_LDA(At, 1, 1); PG8_STAGE(PG8_SB(1, 0), b3, voffB); PG8_STAGE(PG8_SB(1, 1), b3 + hstep, voffB); PG8_STAGE(PG8_SA(1, 0), a3, voffA);
            PG8_WAIT_V(8); PG8_WAIT_L(0); PG8_BAR; PG8_MMA(1, 0, At, B0); PG8_MMA(1, 1, At, B1); PG8_BAR; PG8_SCHED;
            } else {
            PG8_LDB(B0, 0, 0); PG8_SCHED; PG8_LDA(At, 0, 0); PG8_STAGE(PG8_SA(1, 1), a1 + hstep, voffA);
            PG8_WAIT_L(8); PG8_BAR; PG8_WAIT_L(0); PG8_MMA(0, 0, At, B0); PG8_BAR; PG8_SCHED;
            PG8_LDB(B1, 0, 1); PG8_STAGE(PG8_SB(0, 0), b2, voffB);
            PG8_BAR; PG8_WAIT_L(0); PG8_MMA(0, 1, At, B1); PG8_BAR;
            PG8_LDA(At, 0, 1); PG8_STAGE(PG8_SA(0, 0), a2, voffA);
            PG8_BAR; PG8_WAIT_L(0); PG8_MMA(1, 0, At, B0); PG8_BAR; PG8_SCHED;
            PG8_STAGE(PG8_SB(0, 1), b2 + hstep, voffB);
            PG8_WAIT_V(6); PG8_BAR; PG8_MMA(1, 1, At, B1); PG8_BAR;
            PG8_LDB(B0, 1, 0); PG8_SCHED; PG8_LDA(At, 1, 0); PG8_STAGE(PG8_SA(0, 1), a2 + hstep, voffA);
            PG8_WAIT_L(8); PG8_BAR; PG8_WAIT_L(0); PG8_MMA(0, 0, At, B0); PG8_BAR; PG8_SCHED;
            PG8_LDB(B1, 1, 1); PG8_STAGE(PG8_SB(1, 0), b3, voffB);
            PG8_BAR; PG8_WAIT_L(0); PG8_MMA(0, 1, At, B1); PG8_BAR;
            PG8_LDA(At, 1, 1); PG8_STAGE(PG8_SA(1, 0), a3, voffA);
            PG8_BAR; PG8_WAIT_L(0); PG8_MMA(1, 0, At, B0); PG8_BAR; PG8_SCHED;
            PG8_STAGE(PG8_SB(1, 1), b3 + hstep, voffB);
            PG8_WAIT_V(6); PG8_BAR; PG8_MMA(1, 1, At, B1); PG8_BAR;
            }
        }
        if constexpr (ALIGN_EPI) { if (wr == 0) PG8_BAR; }
        if constexpr (!Epi::AFTER_DRAIN) { E(acc, cur, wr, wc, fr, fq); S.done(cur); }
        if (!has_next) break;
#pragma unroll
        for (int a = 0; a < 2; ++a)
#pragma unroll
            for (int b = 0; b < 2; ++b)
#pragma unroll
                for (int m = 0; m < 4; ++m)
#pragma unroll
                    for (int n = 0; n < 2; ++n) acc[a][b][m][n] = (f32x4){0.f, 0.f, 0.f, 0.f};
        cur = nxt; cA = nA; cB = nB; ++ui;
        if constexpr (ALIGN_EPI) { if (wr == 1) PG8_BAR; }
    }
    PG8_WAIT_V(0);
    if constexpr (!ALIGN_EPI) { if (wr == 0) PG8_BAR; }
    PG8_BAR;
    if constexpr (Epi::AFTER_DRAIN) { E.fused(acc, cur, wr, wc, fr, fq, lds, wid, lane); S.done(cur); }
#undef PG8_SA
#undef PG8_SB
#undef PG8_STAGE
#undef PG8_LDA
#undef PG8_LDB
#undef PG8_MMA
#undef PG8_WAIT_V
#undef PG8_WAIT_L
#undef PG8_BAR
#undef PG8_SCHED
}
}

constexpr int NWAVES = 8;
#ifndef MK_SINGLE
#define MK_SINGLE 1
#endif

constexpr int SEQ = 8192, DM = 4096, DEPTH = 2, HD = 128, SSMC = 1024, NSBH = 12, NDLH = 12, SBW = 1536, DLW = 1536, INW = 10240, FFN = 11008, GUW = 2 * FFN;
constexpr int NGRP = 64, NST = 64, SGRP = 16;
constexpr int C_QSB = 0, C_KSB = 1536, C_VSB = 3072, C_QDL = 4608, C_KDL = 6144, C_VDL = 7680, C_USSM = 9216;
constexpr float RMS_EPS = 1e-6f;
constexpr float ATT_SCALE = 0.08838834764831845f;
constexpr int SSM_T = 256, SSM_LOG2T = 8, SSM_NCH = SEQ / SSM_T;
static_assert((1 << SSM_LOG2T) == SSM_T, "SSM_T");
constexpr int STEPS_PER_LAYER = 10, NSTEPS = 1 + DEPTH * STEPS_PER_LAYER;

constexpr size_t MiB = 1u << 20;
constexpr size_t WS_CTL = 0, CTL_ZERO_BYTES = 1 * MiB;
constexpr size_t WS_W = 3 * MiB, WL_BYTES = 372 * MiB;
constexpr size_t WO_IN = 0, WO_GLU = 80 * MiB, WO_OUT = 82 * MiB, WO_GU = 114 * MiB, WO_DN = 286 * MiB;
constexpr size_t WS_XN = 747 * MiB;
constexpr size_t WS_PROJ = 811 * MiB;
constexpr size_t WS_OSB = 971 * MiB;
constexpr size_t WS_H = 811 * MiB;
constexpr size_t WS_MIX = 995 * MiB;
constexpr size_t WS_F = 1059 * MiB;
constexpr size_t WS_X1 = 1123 * MiB;
constexpr size_t WS_ODL = 1251 * MiB;
constexpr size_t WS_G = 1323 * MiB;
constexpr size_t WS_OSSM = 1339 * MiB;
constexpr size_t WS_XE = 1355 * MiB;
constexpr size_t WS_STAT = 1357 * MiB;
constexpr size_t WS_TAB = 1 * MiB;
constexpr size_t WS_END = 1360 * MiB;
static_assert(WS_W + DEPTH * WL_BYTES <= WS_XN && WS_H + (size_t)SEQ * FFN * 2 <= WS_MIX && WS_PROJ + (size_t)SEQ * INW * 2 <= WS_OSB, "d_ws map");
constexpr int CW_TMO = 0, CW_CODE = 1, CW_BAR = 4096;

constexpr int WAVE_LDS = 18432;
constexpr int LDSCTL_OFF = 8 * WAVE_LDS, MISC_OFF = LDSCTL_OFF + 320;
constexpr int LDS_BYTES = 148480;
static_assert(MISC_OFF + 128 <= LDS_BYTES && 8 * WAVE_LDS >= 131072, "LDS map");

#define GAS __attribute__((address_space(1)))
#define LAS __attribute__((address_space(3)))
typedef unsigned short bf16;
typedef unsigned v4u __attribute__((ext_vector_type(4)));
typedef unsigned v2u __attribute__((ext_vector_type(2)));
typedef float f32x4 __attribute__((ext_vector_type(4)));
typedef float f32x2 __attribute__((ext_vector_type(2)));
typedef short bf16x8 __attribute__((ext_vector_type(8)));
typedef GAS unsigned gu32;
#define RLX_AGENT __ATOMIC_RELAXED, __HIP_MEMORY_SCOPE_AGENT
#define LDS_WAIT() asm volatile("s_waitcnt lgkmcnt(0)" ::: "memory")
#define VM_WAIT() asm volatile("s_waitcnt vmcnt(0)" ::: "memory")
__device__ __forceinline__ int fresh_lane() { int l; asm volatile("v_mbcnt_lo_u32_b32 %0, -1, 0\n\tv_mbcnt_hi_u32_b32 %0, -1, %0" : "=v"(l)); return l; }
__device__ __forceinline__ unsigned pk2(float lo, float hi) { return pg8::cvt_pk_bf16(lo, hi); }
__device__ __forceinline__ float bflo(unsigned w) { return __uint_as_float(w << 16); }
__device__ __forceinline__ float bfhi(unsigned w) { return __uint_as_float(w & 0xffff0000u); }
__device__ __forceinline__ float bf2f(bf16 h) { return __uint_as_float((unsigned)h << 16); }
__device__ __forceinline__ float wave_sum(float v) {
#pragma unroll
    for (int o = 1; o < 64; o <<= 1) v += __shfl_xor(v, o);
    return v;
}
__device__ __forceinline__ float wave_max(float v) {
#pragma unroll
    for (int o = 1; o < 64; o <<= 1) v = fmaxf(v, __shfl_xor(v, o));
    return v;
}
#define XB_TMO      128
#define XB_XCNT(j)  (256  + 64 * (j))
#define XB_XSUB(j)  (1280 + 64 * (j))
#define XB_XGEN(j)  (2304 + 64 * (j))
#define XB_TOP      3328
#define XB_TOPGEN   3392
#define XCD_BAR_WORDS 3456
#define XB_SPIN_CAP (1u << 18)

__device__ __forceinline__ unsigned xb_ld(unsigned* p)              { return __hip_atomic_load(p, __ATOMIC_RELAXED, __HIP_MEMORY_SCOPE_AGENT); }
__device__ __forceinline__ unsigned xb_add(unsigned* p, unsigned v) { return __hip_atomic_fetch_add(p, v, __ATOMIC_RELAXED, __HIP_MEMORY_SCOPE_AGENT); }
__device__ __forceinline__ unsigned xb_xcc_id() { return (unsigned)__builtin_amdgcn_s_getreg((3 << 11) | 20) & 0xFu; }
#define XB_SPIN(cond, bar) do { unsigned _sp = 0; while (cond) { __builtin_amdgcn_s_sleep(1); \
    if ((++_sp & 255u) == 0u) { if (xb_ld(&(bar)[XB_TMO])) break; if (_sp > XB_SPIN_CAP) { atomicAdd(&(bar)[XB_TMO], 1u); break; } } } } while (0)

struct XcdBarrier {
    unsigned* bar; unsigned x;
    int w;
    volatile LAS unsigned* st;
};

__device__ __forceinline__ XcdBarrier xcd_barrier_post(unsigned* bar, volatile LAS unsigned* st, int wave) {
    XcdBarrier b; b.bar = bar; b.x = xb_xcc_id(); b.st = st; b.w = wave;
    if (wave == 0 && fresh_lane() == 0) (void)xb_add(&bar[XB_XCNT(b.x)], 1u);
    return b;
}
__device__ __forceinline__ void xcd_barrier_complete(unsigned* bar, unsigned x, unsigned& nloc, unsigned& nx) {
    const unsigned G = gridDim.x * gridDim.y * gridDim.z;
    unsigned sum, cnt, mine, sp = 0u;
    for (;;) {
        sum = 0u; cnt = 0u; mine = 0u;
#pragma unroll
        for (unsigned j = 0; j < 16; ++j) { const unsigned c = xb_ld(&bar[XB_XCNT(j)]); sum += c; cnt += (c > 0u) ? 1u : 0u; mine = (j == x) ? c : mine; }
        if (sum == G) break;
        __builtin_amdgcn_s_sleep(1);
        if ((++sp & 255u) == 0u) { if (xb_ld(&bar[XB_TMO])) break; if (sp > XB_SPIN_CAP) { atomicAdd(&bar[XB_TMO], 1u); break; } }
    }
    nloc = mine > 0u ? mine : 1u; nx = cnt > 0u ? cnt : 1u;
}

__device__ __forceinline__ void xcd_barrier(const XcdBarrier& b) {
    asm volatile("s_waitcnt vmcnt(0)" ::: "memory");
    __syncthreads();
    if (b.w == 0 && fresh_lane() == 0) {
        unsigned* bar = b.bar;
        __builtin_amdgcn_s_waitcnt(0);
        unsigned nloc = b.st[0], nx = b.st[1];
        if (nloc == 0u) { xcd_barrier_complete(bar, b.x, nloc, nx); b.st[0] = nloc; b.st[1] = nx; }
        const unsigned old = xb_add(&bar[XB_XSUB(b.x)], 1u);
        const unsigned gen = old / nloc;
        if (old + 1u == (gen + 1u) * nloc) {
            __builtin_amdgcn_fence(__ATOMIC_RELEASE, "agent");
            asm volatile("s_waitcnt vmcnt(0)" ::: "memory");
            const unsigned og = xb_add(&bar[XB_TOP], 1u);
            const unsigned tg = og / nx;
            if (og + 1u == (tg + 1u) * nx) xb_add(&bar[XB_TOPGEN], 1u);
            else XB_SPIN(xb_ld(&bar[XB_TOPGEN]) == tg, bar);
            __builtin_amdgcn_fence(__ATOMIC_ACQUIRE, "agent");
            xb_add(&bar[XB_XGEN(b.x)], 1u);
            asm volatile("s_waitcnt vmcnt(0)" ::: "memory");
        } else {
            XB_SPIN(xb_ld(&bar[XB_XGEN(b.x)]) == gen, bar);
            __builtin_amdgcn_fence(__ATOMIC_ACQUIRE, "agent");
            asm volatile("s_waitcnt vmcnt(0)" ::: "memory");
        }
    }
    __syncthreads();
}

#ifndef USE_NT
#define USE_NT 1
#endif
#if USE_NT
#define NT_LD(p) __builtin_nontemporal_load(p)
#define NT_ST(p, v) __builtin_nontemporal_store(v, p)
#else
#define NT_LD(p) (*(p))
#define NT_ST(p, v) (*(p) = (v))
#endif
__device__ __forceinline__ void tr_tile(const float* W, int K, int N, bf16* WT, int k0, int n0, int orow0, LAS float* scr, int lane_) {
    int lane = lane_; asm volatile("" : "+v"(lane));
#pragma unroll 4
    for (int i = 0; i < 16; ++i) { const int kk = 4 * i + (lane >> 4), c = (lane & 15) * 4;
        const f32x4 v = *(const f32x4*)(W + (size_t)(k0 + kk) * N + n0 + c);
        LAS float* d = scr + kk * 65 + c; d[0] = v.x; d[1] = v.y; d[2] = v.z; d[3] = v.w; }
    LDS_WAIT(); asm volatile("" ::: "memory");
    const int c8 = lane & 7;
#pragma unroll
    for (int j = 0; j < 8; ++j) { const int n = (lane >> 3) + 8 * j; const LAS float* s = scr + (8 * c8) * 65 + n;
        v4u o; o.x = pk2(s[0], s[65]); o.y = pk2(s[130], s[195]); o.z = pk2(s[260], s[325]); o.w = pk2(s[390], s[455]);
        *(v4u*)(WT + (size_t)(orow0 + n) * K + k0 + 8 * c8) = o; }
    LDS_WAIT(); asm volatile("" ::: "memory");
}

struct ConvItem { const float* W; bf16* WT; int K, N, k0, n0, orow0; };
__device__ __forceinline__ void tr_load(const ConvItem& c, int lane_, f32x4 (&v)[16]) {
    int lane = lane_; asm volatile("" : "+v"(lane));
    const float* src = c.W + (size_t)(c.k0 + (lane >> 4)) * c.N + c.n0 + (lane & 15) * 4;
#pragma unroll
    for (int i = 0; i < 16; ++i) v[i] = NT_LD((const f32x4*)(src + (size_t)(4 * i) * c.N));
}
__device__ __forceinline__ void tr_store(const ConvItem& c, LAS float* scr, int lane_, const f32x4 (&v)[16]) {
    int lane = lane_; asm volatile("" : "+v"(lane));
#pragma unroll
    for (int i = 0; i < 16; ++i) { LAS float* d = scr + (4 * i + (lane >> 4)) * 65 + (lane & 15) * 4; d[0] = v[i].x; d[1] = v[i].y; d[2] = v[i].z; d[3] = v[i].w; }
    LDS_WAIT(); asm volatile("" ::: "memory");
    const int c8 = lane & 7;
#pragma unroll
    for (int j = 0; j < 8; ++j) { const int n = (lane >> 3) + 8 * j; const LAS float* s = scr + (8 * c8) * 65 + n;
        v4u o; o.x = pk2(s[0], s[65]); o.y = pk2(s[130], s[195]); o.z = pk2(s[260], s[325]); o.w = pk2(s[390], s[455]);
        *(v4u*)(c.WT + (size_t)(c.orow0 + n) * c.K + c.k0 + 8 * c8) = o; }
    LDS_WAIT(); asm volatile("" ::: "memory");
}
__device__ __forceinline__ f32x4 ld_row4(const float* p) { return NT_LD((const f32x4*)p); }
__device__ __forceinline__ f32x4 ld_row4(const bf16* p) { const v2u w = NT_LD((const v2u*)p); return (f32x4){bflo(w.x), bfhi(w.x), bflo(w.y), bfhi(w.y)}; }
__device__ __forceinline__ void st_row4(float* p, const f32x4& v) { NT_ST((f32x4*)p, v); }
__device__ __forceinline__ void st_row4(bf16* p, const f32x4& v) { v2u o; o.x = pk2(v.x, v.y); o.y = pk2(v.z, v.w); NT_ST((v2u*)p, o); }
template <typename TI, typename TO>
__device__ __forceinline__ void row_op(const TI* xin, const bf16* f, const float* gpost, TO* xout, const float* gpre, bf16* xn, int lane_) {
    int lane = lane_; asm volatile("" : "+v"(lane));
    f32x4 x[16];
    if (f) {
        v2u fw[16]; float ss = 0.f;
#pragma unroll
        for (int j = 0; j < 16; ++j) { fw[j] = *(const v2u*)(f + 4 * lane + 256 * j);
            const float a = bflo(fw[j].x), b = bfhi(fw[j].x), c = bflo(fw[j].y), d = bfhi(fw[j].y); ss += (a * a + b * b) + (c * c + d * d); }
        const float r1 = 1.0f / sqrtf(wave_sum(ss) * (1.0f / DM) + RMS_EPS);
#pragma unroll
        for (int j = 0; j < 16; ++j) { const f32x4 xv = ld_row4(xin + 4 * lane + 256 * j), gp = *(const f32x4*)(gpost + 4 * lane + 256 * j);
            x[j].x = xv.x + bflo(fw[j].x) * r1 * gp.x; x[j].y = xv.y + bfhi(fw[j].x) * r1 * gp.y; x[j].z = xv.z + bflo(fw[j].y) * r1 * gp.z; x[j].w = xv.w + bfhi(fw[j].y) * r1 * gp.w;
            if ((j & (sizeof(TI) == 2 ? 7 : 3)) == (sizeof(TI) == 2 ? 7 : 3)) asm volatile("" ::: "memory"); }
    } else {
#pragma unroll
        for (int j = 0; j < 16; ++j) x[j] = ld_row4(xin + 4 * lane + 256 * j);
    }
    if (xout) {
#pragma unroll
        for (int j = 0; j < 16; ++j) st_row4(xout + 4 * lane + 256 * j, x[j]);
    }
    if (xn) {
        float s2 = 0.f;
#pragma unroll
        for (int j = 0; j < 16; ++j) s2 += (x[j].x * x[j].x + x[j].y * x[j].y) + (x[j].z * x[j].z + x[j].w * x[j].w);
        const float r2 = 1.0f / sqrtf(wave_sum(s2) * (1.0f / DM) + RMS_EPS);
#pragma unroll
        for (int j = 0; j < 16; ++j) { const f32x4 gp = *(const f32x4*)(gpre + 4 * lane + 256 * j);
            v2u o; o.x = pk2(x[j].x * r2 * gp.x, x[j].y * r2 * gp.y); o.y = pk2(x[j].z * r2 * gp.z, x[j].w * r2 * gp.w);
            *(v2u*)(xn + 4 * lane + 256 * j) = o;
            if ((j & 3) == 3) asm volatile("" ::: "memory"); }
    }
}

__device__ __forceinline__ void gains_to_lds(const float* gpost, const float* gpre, LAS float* gl, int lane_, int wid) {
    int lane = lane_; asm volatile("" : "+v"(lane));
    __syncthreads();
#pragma unroll
    for (int q = 0; q < 2; ++q) { const int i = (q * NWAVES + wid) * 64 + lane;
        ((LAS f32x4*)gl)[i] = ((const f32x4*)gpost)[i]; if (gpre) ((LAS f32x4*)gl)[DM / 4 + i] = ((const f32x4*)gpre)[i]; }
    LDS_WAIT();
    __syncthreads();
}
__device__ __forceinline__ void raw_ld(const float* p, f32x4& r) { r = NT_LD((const f32x4*)p); }
__device__ __forceinline__ void raw_ld(const bf16* p, v2u& r) { r = NT_LD((const v2u*)p); }
__device__ __forceinline__ f32x4 raw_cv(const f32x4& r) { return r; }
__device__ __forceinline__ f32x4 raw_cv(const v2u& w) { return (f32x4){bflo(w.x), bfhi(w.x), bflo(w.y), bfhi(w.y)}; }
template <typename T> struct RawOf { typedef f32x4 type; };
template <> struct RawOf<bf16> { typedef v2u type; };
template <typename TI> struct RowRaw { v2u fw[16]; typename RawOf<TI>::type xw[16]; };
template <typename TI>
__device__ __forceinline__ void row_load(const TI* xin, const bf16* f, int lane_, RowRaw<TI>& R) {
    int lane = lane_; asm volatile("" : "+v"(lane));
#pragma unroll
    for (int j = 0; j < 16; ++j) R.fw[j] = NT_LD((const v2u*)(f + 4 * lane + 256 * j));
#pragma unroll
    for (int j = 0; j < 16; ++j) raw_ld(xin + 4 * lane + 256 * j, R.xw[j]);
}
template <typename TI, typename TO, bool HAS_XN>
__device__ __forceinline__ void row_finish(const RowRaw<TI>& R, const LAS float* gl, TO* xout, bf16* xn, int lane_) {
    int lane = lane_; asm volatile("" : "+v"(lane));
    float ss = 0.f;
#pragma unroll
    for (int j = 0; j < 16; ++j) { const float a = bflo(R.fw[j].x), b = bfhi(R.fw[j].x), c = bflo(R.fw[j].y), d = bfhi(R.fw[j].y); ss += (a * a + b * b) + (c * c + d * d); }
    const float r1 = 1.0f / sqrtf(wave_sum(ss) * (1.0f / DM) + RMS_EPS);
    f32x4 x[16]; float s2 = 0.f;
#pragma unroll
    for (int j = 0; j < 16; ++j) { const f32x4 xv = raw_cv(R.xw[j]), gp = *(const LAS f32x4*)(gl + 4 * lane + 256 * j);
        x[j].x = xv.x + bflo(R.fw[j].x) * r1 * gp.x; x[j].y = xv.y + bfhi(R.fw[j].x) * r1 * gp.y; x[j].z = xv.z + bflo(R.fw[j].y) * r1 * gp.z; x[j].w = xv.w + bfhi(R.fw[j].y) * r1 * gp.w;
        st_row4(xout + 4 * lane + 256 * j, x[j]);
        s2 += (x[j].x * x[j].x + x[j].y * x[j].y) + (x[j].z * x[j].z + x[j].w * x[j].w); }
    if (HAS_XN) {
        const float r2 = 1.0f / sqrtf(wave_sum(s2) * (1.0f / DM) + RMS_EPS);
#pragma unroll
        for (int j = 0; j < 16; ++j) { const f32x4 gp = *(const LAS f32x4*)(gl + DM + 4 * lane + 256 * j);
            v2u o; o.x = pk2(x[j].x * r2 * gp.x, x[j].y * r2 * gp.y); o.y = pk2(x[j].z * r2 * gp.z, x[j].w * r2 * gp.w);
            *(v2u*)(xn + 4 * lane + 256 * j) = o; }
    }
}
template <typename TI, typename TO, bool HAS_XN, bool PREFETCH>
__device__ __forceinline__ void row_phase(const TI* xin, const bf16* f, const LAS float* gl, TO* xout, bf16* xn, int gw, int ngw, int nrows, int lane) {
    if (!PREFETCH) {
        for (int m0 = gw; m0 < nrows; m0 += ngw) { const size_t o = (size_t)(m0 % SEQ) * DM; RowRaw<TI> a; row_load(xin + o, f + o, lane, a); asm volatile("" ::: "memory");
            row_finish<TI, TO, HAS_XN>(a, gl, xout + o, xn + o, lane); }
    } else {
        int m0 = gw; if (m0 >= nrows) return;
        RowRaw<TI> a, b; { const size_t o = (size_t)(m0 % SEQ) * DM; row_load(xin + o, f + o, lane, a); }
        for (;;) {
            const int m1 = m0 + ngw; if (m1 < nrows) { const size_t o = (size_t)(m1 % SEQ) * DM; row_load(xin + o, f + o, lane, b); }
            asm volatile("" ::: "memory");
            { const size_t o = (size_t)(m0 % SEQ) * DM; row_finish<TI, TO, HAS_XN>(a, gl, xout + o, xn + o, lane); }
            if (m1 >= nrows) break;
            const int m2 = m1 + ngw; if (m2 < nrows) { const size_t o = (size_t)(m2 % SEQ) * DM; row_load(xin + o, f + o, lane, a); }
            asm volatile("" ::: "memory");
            { const size_t o = (size_t)(m1 % SEQ) * DM; row_finish<TI, TO, HAS_XN>(b, gl, xout + o, xn + o, lane); }
            if (m2 >= nrows) break;
            m0 = m2;
        }
    }
}

__device__ __forceinline__ float dot128(const v4u (&q)[16], const bf16* kp) {
    float s0 = 0.f, s1 = 0.f;
#pragma unroll
    for (int i = 0; i < 16; ++i) { const v4u kv = *(const v4u*)(kp + 8 * i);
        s0 += bflo(q[i].x) * bflo(kv.x) + bflo(q[i].y) * bflo(kv.y) + bflo(q[i].z) * bflo(kv.z) + bflo(q[i].w) * bflo(kv.w);
        s1 += bfhi(q[i].x) * bfhi(kv.x) + bfhi(q[i].y) * bfhi(kv.y) + bfhi(q[i].z) * bfhi(kv.z) + bfhi(q[i].w) * bfhi(kv.w); }
    return s0 + s1;
}
constexpr float SB_STOP_N = -100.0f;
__device__ __forceinline__ void sb_naive(const bf16* P, bf16* OSB, int h, int t, int lane) {
    v4u q[16];
    { const bf16* qp = P + (size_t)t * INW + C_QSB + h * HD;
#pragma unroll
      for (int i = 0; i < 16; ++i) q[i] = *(const v4u*)(qp + 8 * i); }
    float o0 = 0.f, o1 = 0.f, R = 0.f;
    for (int base = t - 1; base >= 0; base -= 64) {
        const int s = base - lane; const bool valid = s >= 0; const int sc = valid ? s : 0;
        const float z = dot128(q, P + (size_t)sc * INW + C_KSB + h * HD) * ATT_SCALE;
        const float sp = fmaxf(z, 0.f) + __logf(1.0f + __expf(-fabsf(z)));
        const float lb = valid ? -sp : 0.f, ls = z - sp;
        float inc = lb;
#pragma unroll
        for (int o = 1; o < 64; o <<= 1) { const float tv = __shfl_up(inc, o); if (lane >= o) inc += tv; }
        const float a = valid ? __expf(ls + R + inc - lb) : 0.f;
        const float tot = __shfl(inc, 63);
        const int nk = base + 1 < 64 ? base + 1 : 64;
        for (int j = 0; j < nk; ++j) { const float aj = __shfl(a, j); const bf16* vp = P + (size_t)(base - j) * INW + C_VSB + h * HD;
            o0 += aj * bf2f(vp[lane]); o1 += aj * bf2f(vp[lane + 64]); }
        R += tot;
        if (R < SB_STOP_N) break;
    }
    bf16* op = OSB + (size_t)t * SBW + h * HD;
    op[lane] = (bf16)(pk2(o0, 0.f) & 0xffffu); op[lane + 64] = (bf16)(pk2(o1, 0.f) & 0xffffu);
}
__device__ __forceinline__ void dl_naive(const bf16* P, bf16* ODL, int h, int t, int lane) {
    v4u q[16];
    { const bf16* qp = P + (size_t)t * INW + C_QDL + h * HD;
#pragma unroll
      for (int i = 0; i < 16; ++i) q[i] = *(const v4u*)(qp + 8 * i); }
    float o0 = 0.f, o1 = 0.f, m = -1e30f, l = 0.f;
    for (int b = 0; b < 3; ++b) { const int d = b == 0 ? 1 : (b == 1 ? 4 : 16);
        for (int it = 0; it < 3; ++it) {
            const int j = it * 64 + lane, pos = t - j * d; const bool valid = (j <= 128) && (pos >= 0); const int pc = valid ? pos : 0;
            if (t - it * 64 * d < 0) break;
            const float s = dot128(q, P + (size_t)pc * INW + C_KDL + h * HD) * ATT_SCALE;
            const float tm = wave_max(valid ? s : -1e30f);
            const float mn = fmaxf(m, tm), alpha = __expf(m - mn);
            const float p = valid ? __expf(s - mn) : 0.f;
            l = l * alpha + wave_sum(p); o0 *= alpha; o1 *= alpha; m = mn;
            const int nj = it == 2 ? 1 : 64;
            for (int jj = 0; jj < nj; ++jj) { const int pp = t - (it * 64 + jj) * d; if (pp < 0) break;
                const float pj = __shfl(p, jj); const bf16* vp = P + (size_t)pp * INW + C_VDL + h * HD;
                o0 += pj * bf2f(vp[lane]); o1 += pj * bf2f(vp[lane + 64]); }
        }
    }
    const float rl = 1.0f / l;
    bf16* op = ODL + (size_t)t * DLW + h * HD;
    op[lane] = (bf16)(pk2(o0 * rl, 0.f) & 0xffffu); op[lane + 64] = (bf16)(pk2(o1 * rl, 0.f) & 0xffffu);
}

#ifndef EXP_OLDSSM
#define EXP_OLDSSM 0
#endif
#ifndef EXP_MFMA_PAD
#define EXP_MFMA_PAD 0
#endif
#ifndef EXP_UGLOBAL
#define EXP_UGLOBAL 0
#endif
struct SsmW { const float *lam_re, *lam_im, *log_dt, *b_re, *b_im, *c_re, *c_im, *dsk; };
struct SsmRegs { float ar, ai, atr, ati, dsk; bf16x8 bfr[8]; bf16x8 cf[4]; };
template <bool PASS2>
__device__ __forceinline__ void ssm_build(const SsmW& w, int g, int lane_, SsmRegs& R) {
    int lane = lane_; asm volatile("" : "+v"(lane));
    const float a_re = fminf(w.lam_re[g * NST + lane], -1e-4f), a_im = w.lam_im[g * NST + lane], dt = expf(w.log_dt[g]);
    const float mag = expf(dt * a_re), ang = dt * a_im;
    const float ar = mag * cosf(ang), ai = mag * sinf(ang);
    const float den = a_re * a_re + a_im * a_im, nr = ar - 1.0f;
    const float f_re = (nr * a_re + ai * a_im) / den, f_im = (ai * a_re - nr * a_im) / den;
    R.ar = ar; R.ai = ai;
    float tr = ar, ti = ai;
#pragma unroll
    for (int s = 0; s < SSM_LOG2T; ++s) { const float n2r = tr * tr - ti * ti, n2i = 2.0f * tr * ti; tr = n2r; ti = n2i; }
    R.atr = tr; R.ati = ti;
    const int n16 = lane & 15, kq = lane >> 4;
#pragma unroll
    for (int j = 0; j < 8; ++j) { const int np = (16 * j + n16) & 63; const float fr = __shfl(f_re, np), fi = __shfl(f_im, np);
        const float* brp = w.b_re + (size_t)(g * NST + np) * SGRP + 8 * (kq & 1); const float* bip = w.b_im + (size_t)(g * NST + np) * SGRP + 8 * (kq & 1);
        const f32x4 r0 = *(const f32x4*)brp, r1 = *(const f32x4*)(brp + 4), i0 = *(const f32x4*)bip, i1 = *(const f32x4*)(bip + 4);
        float v[8];
#pragma unroll
        for (int e = 0; e < 4; ++e) { v[e] = j < 4 ? fr * r0[e] - fi * i0[e] : fr * i0[e] + fi * r0[e]; v[4 + e] = j < 4 ? fr * r1[e] - fi * i1[e] : fr * i1[e] + fi * r1[e]; }
        v4u o; o.x = pk2(v[0], v[1]); o.y = pk2(v[2], v[3]); o.z = pk2(v[4], v[5]); o.w = pk2(v[6], v[7]);
        if (kq >= 2) o = (v4u){0u, 0u, 0u, 0u};
        R.bfr[j] = __builtin_bit_cast(bf16x8, o); }
    if (PASS2) {
#pragma unroll
        for (int kk = 0; kk < 4; ++kk) { const size_t co = (size_t)(g * SGRP + n16) * NST + kk * 16 + 4 * kq;
            const f32x4 cr = *(const f32x4*)(w.c_re + co), ci = *(const f32x4*)(w.c_im + co);
            v4u o; o.x = pk2(cr.x, -ci.x); o.y = pk2(cr.y, -ci.y); o.z = pk2(cr.z, -ci.z); o.w = pk2(cr.w, -ci.w);
            R.cf[kk] = __builtin_bit_cast(bf16x8, o); }
        R.dsk = w.dsk[g * SGRP + n16];
    }
}
constexpr int BU_PITCH = 20;
template <bool PASS2>
__device__ __forceinline__ void ssm_unit(const bf16* P, const SsmW& w, float* xe, bf16* Gout, int g, int ch, LAS unsigned char* wl, int lane_) {
    int lane = lane_; asm volatile("" : "+v"(lane));
    const int tb = ch * SSM_T;
    LAS float* BU = (LAS float*)wl;
    LAS bf16* X = (LAS bf16*)wl;
    LAS bf16* UA = (LAS bf16*)(wl + 128 * BU_PITCH * 4);
    static_assert(128 * BU_PITCH * 4 + SSM_T * 32 <= WAVE_LDS, "S5 LDS map");
        const bf16* src = P + (size_t)(tb + (lane >> 1)) * INW + C_USSM + g * SGRP + 8 * (lane & 1);
        v4u s4[SSM_T / 32];
#pragma unroll
        for (int q = 0; q < SSM_T / 32; ++q) s4[q] = *(const v4u*)(src + (size_t)q * 32 * INW);
    f32x2 e0[32];
    if (PASS2) {
#pragma unroll
        for (int q = 0; q < 32; ++q) { const int j = q < ch ? q : (ch > 0 ? ch - 1 : 0); e0[q] = *(const f32x2*)(xe + ((size_t)(j * NGRP + g) * NST + lane) * 2); }
    }
    SsmRegs R; ssm_build<PASS2>(w, g, lane, R);
#pragma unroll
        for (int q = 0; q < SSM_T / 32; ++q) *(LAS v4u*)(UA + (q * 32 + (lane >> 1)) * 16 + 8 * (lane & 1)) = s4[q];
    const int n16 = lane & 15, kq = lane >> 4;
    const float ar = R.ar, ai = R.ai;
    float xr = 0.f, xi = 0.f;
    if (PASS2) {
#pragma unroll
        for (int q = 0; q < 32; ++q) if (q < ch) { const float nr = R.atr * xr - R.ati * xi + e0[q].x, ni = R.atr * xi + R.ati * xr + e0[q].y; xr = nr; xi = ni; }
        for (int j0 = 32; j0 < ch; j0 += 32) { f32x2 e[32];
#pragma unroll
            for (int q = 0; q < 32; ++q) { const int j = j0 + q < ch ? j0 + q : ch - 1; e[q] = *(const f32x2*)(xe + ((size_t)(j * NGRP + g) * NST + lane) * 2); }
#pragma unroll
            for (int q = 0; q < 32; ++q) if (j0 + q < ch) { const float nr = R.atr * xr - R.ati * xi + e[q].x, ni = R.atr * xi + R.ati * xr + e[q].y; xr = nr; xi = ni; } }
    }
    VM_WAIT(); LDS_WAIT(); asm volatile("" ::: "memory");
    for (int blk = 0; blk < SSM_T / 16; ++blk) {
        v4u aw = *(const LAS v4u*)(UA + (blk * 16 + n16) * 16 + 8 * (kq & 1));
        LDS_WAIT(); asm volatile("" ::: "memory");
        if (kq >= 2) aw = (v4u){0u, 0u, 0u, 0u};
        const bf16x8 af = __builtin_bit_cast(bf16x8, aw);
        f32x4 dd[8];
#pragma unroll
        for (int j = 0; j < 8; ++j) dd[j] = __builtin_amdgcn_mfma_f32_16x16x32_bf16(af, R.bfr[j], (f32x4){0.f, 0.f, 0.f, 0.f}, 0, 0, 0);
        asm volatile("" : "+v"(dd[0]), "+v"(dd[1]), "+v"(dd[2]), "+v"(dd[3]), "+v"(dd[4]), "+v"(dd[5]), "+v"(dd[6]), "+v"(dd[7]));
#pragma unroll
        for (int j = 0; j < 8; ++j) *(LAS f32x4*)(BU + (16 * j + n16) * BU_PITCH + 4 * kq) = dd[j];
        LDS_WAIT(); asm volatile("" ::: "memory");
        f32x4 br[4], bi[4];
#pragma unroll
        for (int q = 0; q < 4; ++q) { br[q] = *(const LAS f32x4*)(BU + lane * BU_PITCH + 4 * q); bi[q] = *(const LAS f32x4*)(BU + (64 + lane) * BU_PITCH + 4 * q); }
        LDS_WAIT(); asm volatile("" ::: "memory");
#pragma unroll
        for (int tt = 0; tt < 16; ++tt) { const float nr = ar * xr - ai * xi + br[tt >> 2][tt & 3], ni = ar * xi + ai * xr + bi[tt >> 2][tt & 3]; xr = nr; xi = ni;
            if (PASS2) { *(LAS unsigned*)(X + tt * 128 + 2 * lane) = pk2(xr, xi);
                if ((tt & 7) == 7) { LDS_WAIT(); asm volatile("" ::: "memory"); } } }
        if (PASS2) {
            LDS_WAIT(); asm volatile("" ::: "memory");
            f32x4 acc = (f32x4){0.f, 0.f, 0.f, 0.f};
            bf16x8 xf[4];
#pragma unroll
            for (int kk = 0; kk < 4; ++kk) xf[kk] = *(const LAS bf16x8*)((LAS unsigned char*)X + n16 * 256 + kk * 64 + kq * 16);
            bf16 uu[4];
#pragma unroll
            for (int r = 0; r < 4; ++r) uu[r] = UA[(blk * 16 + 4 * kq + r) * 16 + n16];
            LDS_WAIT(); asm volatile("" ::: "memory");
#pragma unroll
            for (int kk = 0; kk < 4; ++kk) acc = __builtin_amdgcn_mfma_f32_16x16x32_bf16(xf[kk], R.cf[kk], acc, 0, 0, 0);
#pragma unroll
            for (int r = 0; r < 4; ++r) { const float u = bf2f(uu[r]);
                const float y = acc[r] + R.dsk * u;
                const float th = 1.0f - 2.0f * __builtin_amdgcn_rcpf(1.0f + __expf(2.0f * 0.7978845608028654f * (y + 0.044715f * y * y * y)));
                UA[(blk * 16 + 4 * kq + r) * 16 + n16] = (bf16)(pk2(0.5f * y * (1.0f + th), 0.f) & 0xffffu); }
        }
        LDS_WAIT(); asm volatile("" ::: "memory");
    }
    if (PASS2) {
        v4u o4[SSM_T / 32];
#pragma unroll
        for (int q = 0; q < SSM_T / 32; ++q) o4[q] = *(const LAS v4u*)(UA + (q * 32 + (lane >> 1)) * 16 + 8 * (lane & 1));
        LDS_WAIT(); asm volatile("" ::: "memory");
        bf16* dst = Gout + (size_t)(tb + (lane >> 1)) * SSMC + g * SGRP + 8 * (lane & 1);
#pragma unroll
        for (int q = 0; q < SSM_T / 32; ++q) *(v4u*)(dst + (size_t)q * 32 * SSMC) = o4[q];
    }
    if (!PASS2) *(f32x2*)(xe + ((size_t)(ch * NGRP + g) * NST + lane) * 2) = (f32x2){xr, xi};
}

#if EXP_OLDSSM
struct SsmWOld { const float *lam_re, *lam_im, *log_dt, *b_re, *b_im, *c_re, *c_im, *dsk; };
__device__ __forceinline__ void ssm_params_old(const SsmWOld& w, int g, int n, float& ar, float& ai, float (&bre)[16], float (&bim)[16]) {
    const float a_re = fminf(w.lam_re[g * NST + n], -1e-4f), a_im = w.lam_im[g * NST + n], dt = expf(w.log_dt[g]);
    const float mag = expf(dt * a_re), ang = dt * a_im;
    ar = mag * cosf(ang); ai = mag * sinf(ang);
    const float den = a_re * a_re + a_im * a_im, nr = ar - 1.0f;
    const float f_re = (nr * a_re + ai * a_im) / den, f_im = (ai * a_re - nr * a_im) / den;
#pragma unroll
    for (int c4 = 0; c4 < 4; ++c4) { const f32x4 br = *(const f32x4*)(w.b_re + (size_t)(g * NST + n) * SGRP + 4 * c4), bi = *(const f32x4*)(w.b_im + (size_t)(g * NST + n) * SGRP + 4 * c4);
#pragma unroll
        for (int e = 0; e < 4; ++e) { bre[4 * c4 + e] = f_re * br[e] - f_im * bi[e]; bim[4 * c4 + e] = f_re * bi[e] + f_im * br[e]; } }
}
__device__ __forceinline__ void ssm_stage_u_old(const bf16* P, int g, int tb, LAS unsigned char* wl, int lane) {
#pragma unroll
    for (int rr = 0; rr < 2; ++rr) { const int t = 2 * lane + rr; const bf16* up = P + (size_t)(tb + t) * INW + C_USSM + g * SGRP;
        const v4u a = *(const v4u*)up, b = *(const v4u*)(up + 8);
        LAS f32x4* d = (LAS f32x4*)(wl + t * 64);
        d[0] = (f32x4){bflo(a.x), bfhi(a.x), bflo(a.y), bfhi(a.y)}; d[1] = (f32x4){bflo(a.z), bfhi(a.z), bflo(a.w), bfhi(a.w)};
        d[2] = (f32x4){bflo(b.x), bfhi(b.x), bflo(b.y), bfhi(b.y)}; d[3] = (f32x4){bflo(b.z), bfhi(b.z), bflo(b.w), bfhi(b.w)}; }
    LDS_WAIT(); asm volatile("" ::: "memory");
}
__device__ __forceinline__ void ssm_step_old(const LAS unsigned char* wl, int t, float ar, float ai, const float (&bre)[16], const float (&bim)[16], float& xr, float& xi) {
    const LAS f32x4* up = (const LAS f32x4*)(wl + t * 64);
    float br = 0.f, bi = 0.f;
#pragma unroll
    for (int c4 = 0; c4 < 4; ++c4) { const f32x4 u = up[c4];
#pragma unroll
        for (int e = 0; e < 4; ++e) { br += bre[4 * c4 + e] * u[e]; bi += bim[4 * c4 + e] * u[e]; } }
    const float nr = ar * xr - ai * xi + br, ni = ar * xi + ai * xr + bi; xr = nr; xi = ni;
}
__device__ __forceinline__ void ssm_pass1_old(const bf16* P, const SsmWOld& w, float* xe, int g, int ch, LAS unsigned char* wl, int lane_) {
    int lane = lane_; asm volatile("" : "+v"(lane));
    float ar, ai, bre[16], bim[16]; ssm_params_old(w, g, lane, ar, ai, bre, bim);
    ssm_stage_u_old(P, g, ch * SSM_T, wl, lane);
    float xr = 0.f, xi = 0.f;
    for (int t = 0; t < SSM_T; ++t) ssm_step_old(wl, t, ar, ai, bre, bim, xr, xi);
    *(f32x2*)(xe + ((size_t)(ch * NGRP + g) * NST + lane) * 2) = (f32x2){xr, xi};
    LDS_WAIT(); asm volatile("" ::: "memory");
}
__device__ __forceinline__ void ssm_pass2_old(const bf16* P, const SsmWOld& w, const float* xe, bf16* Gout, int g, int ch, LAS unsigned char* wl, int lane_) {
    int lane = lane_; asm volatile("" : "+v"(lane));
    float ar, ai, bre[16], bim[16]; ssm_params_old(w, g, lane, ar, ai, bre, bim);
    float tr = ar, ti = ai;
#pragma unroll
    for (int s = 0; s < SSM_LOG2T; ++s) { const float nr = tr * tr - ti * ti, ni = 2.0f * tr * ti; tr = nr; ti = ni; }
    float xr = 0.f, xi = 0.f;
    for (int j = 0; j < ch; ++j) { const f32x2 e = *(const f32x2*)(xe + ((size_t)(j * NGRP + g) * NST + lane) * 2);
        const float nr = tr * xr - ti * xi + e.x, ni = tr * xi + ti * xr + e.y; xr = nr; xi = ni; }
    const int tb = ch * SSM_T;
    ssm_stage_u_old(P, g, tb, wl, lane);
    const int c = lane & 15, kq = lane >> 4;
    bf16x8 cf[4];
#pragma unroll
    for (int kk = 0; kk < 4; ++kk) { const float* src = (kk < 2 ? w.c_re : w.c_im) + (size_t)(g * SGRP + c) * NST + (kk & 1) * 32 + 8 * kq;
        const f32x4 v0 = *(const f32x4*)src, v1 = *(const f32x4*)(src + 4); const float sg = kk < 2 ? 1.0f : -1.0f;
        v4u pkd; pkd.x = pk2(sg * v0.x, sg * v0.y); pkd.y = pk2(sg * v0.z, sg * v0.w); pkd.z = pk2(sg * v1.x, sg * v1.y); pkd.w = pk2(sg * v1.z, sg * v1.w);
        cf[kk] = __builtin_bit_cast(bf16x8, pkd); }
    const float dsk = w.dsk[g * SGRP + c];
    LAS bf16* X = (LAS bf16*)(wl + 8192);
    for (int blk = 0; blk < SSM_T / 16; ++blk) {
#pragma unroll 4
        for (int tt = 0; tt < 16; ++tt) { ssm_step_old(wl, blk * 16 + tt, ar, ai, bre, bim, xr, xi);
            const unsigned pkx = pk2(xr, xi); X[tt * 128 + lane] = (bf16)(pkx & 0xffffu); X[tt * 128 + 64 + lane] = (bf16)(pkx >> 16); }
        LDS_WAIT(); asm volatile("" ::: "memory");
        f32x4 acc = (f32x4){0.f, 0.f, 0.f, 0.f};
#pragma unroll
        for (int kk = 0; kk < 4; ++kk) { const bf16x8 af = *(const LAS bf16x8*)(wl + 8192 + c * 256 + kk * 64 + kq * 16);
            acc = __builtin_amdgcn_mfma_f32_16x16x32_bf16(af, cf[kk], acc, 0, 0, 0); }
#pragma unroll
        for (int r = 0; r < 4; ++r) { const int t = blk * 16 + 4 * kq + r;
#if EXP_UGLOBAL
            const float u = bf2f(P[(size_t)(tb + t) * INW + C_USSM + g * SGRP + c]);
#else
            const float u = ((const LAS float*)wl)[t * 16 + c];
#endif

            const float y = acc[r] + dsk * u;
            const float th = 1.0f - 2.0f * __builtin_amdgcn_rcpf(1.0f + __expf(2.0f * 0.7978845608028654f * (y + 0.044715f * y * y * y)));
            const float gl = 0.5f * y * (1.0f + th);
            Gout[(size_t)(tb + t) * SSMC + g * SGRP + c] = (bf16)(pk2(gl, 0.f) & 0xffffu); }
        LDS_WAIT(); asm volatile("" ::: "memory");
    }
}

#endif
template <int NCH>
__device__ __forceinline__ void seg_norm(const bf16* src, const float* gain, bf16* dst, int lane_) {
    int lane = lane_; asm volatile("" : "+v"(lane));
    v4u a[NCH]; float ss = 0.f;
#pragma unroll
    for (int i = 0; i < NCH; ++i) { a[i] = *(const v4u*)(src + 8 * lane + 512 * i);
        ss += (bflo(a[i].x) * bflo(a[i].x) + bfhi(a[i].x) * bfhi(a[i].x)) + (bflo(a[i].y) * bflo(a[i].y) + bfhi(a[i].y) * bfhi(a[i].y))
            + (bflo(a[i].z) * bflo(a[i].z) + bfhi(a[i].z) * bfhi(a[i].z)) + (bflo(a[i].w) * bflo(a[i].w) + bfhi(a[i].w) * bfhi(a[i].w)); }
    const float r = 1.0f / sqrtf(wave_sum(ss) * (1.0f / (NCH * 512)) + RMS_EPS);
#pragma unroll
    for (int i = 0; i < NCH; ++i) { const f32x4 g0 = *(const f32x4*)(gain + 8 * lane + 512 * i), g1 = *(const f32x4*)(gain + 8 * lane + 512 * i + 4);
        v4u o; o.x = pk2(bflo(a[i].x) * r * g0.x, bfhi(a[i].x) * r * g0.y); o.y = pk2(bflo(a[i].y) * r * g0.z, bfhi(a[i].y) * r * g0.w);
        o.z = pk2(bflo(a[i].z) * r * g1.x, bfhi(a[i].z) * r * g1.y); o.w = pk2(bflo(a[i].w) * r * g1.z, bfhi(a[i].w) * r * g1.w);
        *(v4u*)(dst + 8 * lane + 512 * i) = o; }
}


typedef float f32x16 __attribute__((ext_vector_type(16)));
typedef short s16x4 __attribute__((ext_vector_type(4)));
__device__ __forceinline__ int crow(int r, int hi) { return (r & 3) + 8 * (r >> 2) + 4 * hi; }
__device__ __forceinline__ int v_st(int k, int c) { const int kk = (k & ~0xC) | ((k & 4) << 1) | ((k & 8) >> 1); return ((kk >> 3) * 4 + (c >> 5)) * 512 + ((kk & 7) * 32 + (c & 31)) * 2; }
__device__ __forceinline__ int v_rd_base(int lane) { return ((lane & 3) << 3) | (((lane >> 2) & 3) << 6) | (((lane >> 4) & 1) << 5) | (((lane >> 5) & 1) << 8); }
constexpr int v_rd_off(int d0, int ks, int half) { return d0 * 512 + ks * 4096 + half * 2048; }
template <int OFF> __device__ __forceinline__ s16x4 tr_read(int vb) {
    s16x4 r; asm volatile("ds_read_b64_tr_b16 %0, %1 offset:%2" : "=&v"(r) : "v"(vb), "i"(OFF) : "memory"); return r;
}
template <int D0> __device__ __forceinline__ void pv_one(f32x16& od, int vb, bf16x8 pa0, bf16x8 pa1, bf16x8 pa2, bf16x8 pa3) {
    const s16x4 l0 = tr_read<v_rd_off(D0, 0, 0)>(vb), h0 = tr_read<v_rd_off(D0, 0, 1)>(vb), l1 = tr_read<v_rd_off(D0, 1, 0)>(vb), h1 = tr_read<v_rd_off(D0, 1, 1)>(vb);
    const s16x4 l2 = tr_read<v_rd_off(D0, 2, 0)>(vb), h2 = tr_read<v_rd_off(D0, 2, 1)>(vb), l3 = tr_read<v_rd_off(D0, 3, 0)>(vb), h3 = tr_read<v_rd_off(D0, 3, 1)>(vb);
    asm volatile("s_waitcnt lgkmcnt(0)" ::: "memory"); __builtin_amdgcn_sched_barrier(0);
#define PKV(L, H) (bf16x8){L[0], L[1], L[2], L[3], H[0], H[1], H[2], H[3]}
    od = __builtin_amdgcn_mfma_f32_32x32x16_bf16(pa0, PKV(l0, h0), od, 0, 0, 0);
    od = __builtin_amdgcn_mfma_f32_32x32x16_bf16(pa1, PKV(l1, h1), od, 0, 0, 0);
    od = __builtin_amdgcn_mfma_f32_32x32x16_bf16(pa2, PKV(l2, h2), od, 0, 0, 0);
    od = __builtin_amdgcn_mfma_f32_32x32x16_bf16(pa3, PKV(l3, h3), od, 0, 0, 0);
#undef PKV
}
__device__ __forceinline__ void pack_p(const f32x16& p0, const f32x16& p1, bf16x8& pa0, bf16x8& pa1, bf16x8& pa2, bf16x8& pa3) {
#define PK4(P, BASE, OUT) do { const unsigned a0 = pk2(P[BASE + 0], P[BASE + 1]), a1 = pk2(P[BASE + 2], P[BASE + 3]), b0 = pk2(P[BASE + 4], P[BASE + 5]), b1 = pk2(P[BASE + 6], P[BASE + 7]); \
        const auto r0 = __builtin_amdgcn_permlane32_swap(a0, b0, false, false); const auto r1 = __builtin_amdgcn_permlane32_swap(a1, b1, false, false); \
        v4u w = {r0[0], r1[0], r0[1], r1[1]}; OUT = __builtin_bit_cast(bf16x8, w); } while (0)
    PK4(p0, 0, pa0); PK4(p0, 8, pa1); PK4(p1, 0, pa2); PK4(p1, 8, pa3);
#undef PK4
}
#ifndef K_VIA_LDS
#define K_VIA_LDS 1
#endif
#ifndef V_FIRST_N
#define V_FIRST_N 5
#endif
constexpr int V_FIRST = V_FIRST_N;
struct VPend { v4u vv[16 - V_FIRST]; };
__device__ __forceinline__ void tile_qk(const bf16* P, int rowb, int rstride, int kcol, int vcol, const bf16x8 (&qr)[8], LAS unsigned char* wl, int lane, f32x16& p0, f32x16& p1, VPend& pend) {
    const int r32 = lane & 31, hi = lane >> 5, lq = lane >> 4, c = (lane & 15) * 8;
    const unsigned voff = (unsigned)(lq * rstride) * INW + vcol + c;
    LAS unsigned char* const vdst = wl + (c >> 5) * 512 + (lq * 32 + (c & 31)) * 2;
#if K_VIA_LDS
    const unsigned koff = (unsigned)(lq * rstride) * INW + kcol + c;
    v4u kw[16];
#pragma unroll
    for (int j = 0; j < 16; ++j) { const bf16* rowp = P + (size_t)(rowb + 4 * j * rstride) * INW; kw[j] = *(const v4u*)(rowp + koff); }
    v4u va[V_FIRST];
#pragma unroll
    for (int j = 0; j < V_FIRST; ++j) { const bf16* rowp = P + (size_t)(rowb + 4 * j * rstride) * INW; va[j] = *(const v4u*)(rowp + voff); }
    asm volatile("" ::: "memory");
    { LAS unsigned char* const kdst = wl + lq * 272 + (lane & 15) * 16;
#pragma unroll
      for (int j = 0; j < 16; ++j) *(LAS v4u*)(kdst + j * 4 * 272) = kw[j]; }
    LDS_WAIT(); asm volatile("" ::: "memory");
    bf16x8 kf0[8], kf1[8];
    { const LAS unsigned char* const ksrc = wl + r32 * 272 + hi * 16;
#pragma unroll
      for (int d0 = 0; d0 < 8; ++d0) { kf0[d0] = *(const LAS bf16x8*)(ksrc + d0 * 32); kf1[d0] = *(const LAS bf16x8*)(ksrc + 32 * 272 + d0 * 32); } }
    LDS_WAIT(); asm volatile("" ::: "memory");
#else
    const bf16* const k0p = P + (size_t)rowb * INW; const bf16* const k1p = P + (size_t)(rowb + 32 * rstride) * INW;
    const unsigned koff = (unsigned)(r32 * rstride) * INW + kcol + hi * 8;
    bf16x8 kf0[8], kf1[8];
#pragma unroll
    for (int d0 = 0; d0 < 8; ++d0) { kf0[d0] = *(const bf16x8*)(k0p + koff + d0 * 16); kf1[d0] = *(const bf16x8*)(k1p + koff + d0 * 16); }
    v4u va[V_FIRST];
#pragma unroll
    for (int j = 0; j < V_FIRST; ++j) { const bf16* rowp = P + (size_t)(rowb + 4 * j * rstride) * INW; va[j] = *(const v4u*)(rowp + voff); }
    asm volatile("" ::: "memory");
#endif
    p0 = (f32x16){}; p1 = (f32x16){};
#pragma unroll
    for (int d0 = 0; d0 < 8; ++d0) { p0 = __builtin_amdgcn_mfma_f32_32x32x16_bf16(kf0[d0], qr[d0], p0, 0, 0, 0); p1 = __builtin_amdgcn_mfma_f32_32x32x16_bf16(kf1[d0], qr[d0], p1, 0, 0, 0); }
#pragma unroll
    for (int j = 0; j < V_FIRST; ++j) *(LAS v4u*)(vdst + ((j & 1) + 2 * (j >> 2)) * 2048 + ((j >> 1) & 1) * 256) = va[j];
#pragma unroll
    for (int j = V_FIRST; j < 16; ++j) { const bf16* rowp = P + (size_t)(rowb + 4 * j * rstride) * INW; pend.vv[j - V_FIRST] = *(const v4u*)(rowp + voff); }
    asm volatile("" ::: "memory");
}
__device__ __forceinline__ void tile_v_finish(LAS unsigned char* wl, int lane, const VPend& pend) {
    const int lq = lane >> 4, c = (lane & 15) * 8;
    LAS unsigned char* const vdst = wl + (c >> 5) * 512 + (lq * 32 + (c & 31)) * 2;
#pragma unroll
    for (int j = V_FIRST; j < 16; ++j) *(LAS v4u*)(vdst + ((j & 1) + 2 * (j >> 2)) * 2048 + ((j >> 1) & 1) * 256) = pend.vv[j - V_FIRST];
}
__device__ __forceinline__ void strip_q_issue(const bf16* P, int qrow0, int qstride, int qcol, int lane, v4u (&qw)[8]) {
    const unsigned qoff = (unsigned)((lane >> 4) * qstride) * INW + qcol + (lane & 15) * 8;
#pragma unroll
    for (int j = 0; j < 8; ++j) { const bf16* rowp = P + (size_t)(qrow0 + 4 * j * qstride) * INW; qw[j] = *(const v4u*)(rowp + qoff); }
}
__device__ __forceinline__ void strip_q_none(v4u (&qw)[8]) {
#pragma unroll
    for (int j = 0; j < 8; ++j) qw[j] = (v4u){0u, 0u, 0u, 0u};
}
__device__ __forceinline__ void strip_q_finish(LAS unsigned char* wl, int lane, const v4u (&qw)[8], bf16x8 (&qr)[8]) {
    const int r32 = lane & 31, hi = lane >> 5, lq = lane >> 4;
    { LAS unsigned char* const qdst = wl + lq * 272 + (lane & 15) * 16;
#pragma unroll
      for (int j = 0; j < 8; ++j) *(LAS v4u*)(qdst + j * 4 * 272) = qw[j]; }
    LDS_WAIT(); asm volatile("" ::: "memory");
    { const LAS unsigned char* const qsrc = wl + r32 * 272 + hi * 16;
#pragma unroll
      for (int d0 = 0; d0 < 8; ++d0) qr[d0] = *(const LAS bf16x8*)(qsrc + d0 * 32); }
    LDS_WAIT(); asm volatile("" ::: "memory");
}
__device__ __forceinline__ void strip_o_store(bf16* O, int orow0, int ostride, int ldo, int ocol, LAS unsigned char* wl, int lane) {
    const int lq = lane >> 4;
    LDS_WAIT(); asm volatile("" ::: "memory");
    v4u ow[8];
    { const LAS unsigned char* const osrc = wl + lq * 272 + (lane & 15) * 16;
#pragma unroll
      for (int j = 0; j < 8; ++j) ow[j] = *(const LAS v4u*)(osrc + j * 4 * 272); }
    LDS_WAIT(); asm volatile("" ::: "memory");
    const unsigned ooff = (unsigned)(lq * ostride) * ldo + ocol + (lane & 15) * 8;
#pragma unroll
    for (int j = 0; j < 8; ++j) { bf16* rowp = O + (size_t)(orow0 + 4 * j * ostride) * ldo; *(v4u*)(rowp + ooff) = ow[j]; }
}
constexpr float SB_STOP = 1e-37f;
__device__ __forceinline__ void sb_strip(const bf16* P, bf16* OSB, int h, int t0, LAS unsigned char* wl, int lane_, v4u (&qw)[8], bool has_next, int nq_row0, int nq_stride, int nq_col) {
    int lane = lane_; asm volatile("" : "+v"(lane));
    const int r32 = lane & 31, hi = lane >> 5;
    bf16x8 qr[8];
    strip_q_finish(wl, lane, qw, qr);
    f32x16 o[4] = {}; float R = 1.f;
    const int vb = (int)(uintptr_t)wl + v_rd_base(lane);
    const int tq = t0 + r32;
    for (int jt = t0 >> 6; jt >= 0; --jt) {
        const int kb = jt * 64;
        f32x16 p0, p1;
        VPend pend; tile_qk(P, kb, 1, C_KSB + h * HD, C_VSB + h * HD, qr, wl, lane, p0, p1, pend);
#pragma unroll
        for (int r = 0; r < 16; ++r) {
            { const float z = fminf(fmaxf(p0[r] * ATT_SCALE, -80.f), 80.f), q = __builtin_amdgcn_rcpf(1.0f + __expf(z)); p0[r] = (kb + crow(r, hi) < tq) ? q : 1.0f; }
            { const float z = fminf(fmaxf(p1[r] * ATT_SCALE, -80.f), 80.f), q = __builtin_amdgcn_rcpf(1.0f + __expf(z)); p1[r] = (kb + 32 + crow(r, hi) < tq) ? q : 1.0f; }
        }
        float G0[4], G1[4], Q0[4], Q1[4];
#pragma unroll
        for (int q = 0; q < 4; ++q) { G0[q] = (p0[4 * q] * p0[4 * q + 1]) * (p0[4 * q + 2] * p0[4 * q + 3]); G1[q] = (p1[4 * q] * p1[4 * q + 1]) * (p1[4 * q + 2] * p1[4 * q + 3]);
            Q0[q] = __shfl_xor(G0[q], 32); Q1[q] = __shfl_xor(G1[q], 32); }
        float run = 1.f, S0[4], S1[4];
#pragma unroll
        for (int q = 3; q >= 0; --q) { S1[q] = hi == 0 ? run * Q1[q] : run; run *= G1[q] * Q1[q]; }
#pragma unroll
        for (int q = 3; q >= 0; --q) { S0[q] = hi == 0 ? run * Q0[q] : run; run *= G0[q] * Q0[q]; }
#pragma unroll
        for (int q = 0; q < 4; ++q) {
            float e1 = R * S1[q], e0 = R * S0[q];
#pragma unroll
            for (int i = 3; i >= 0; --i) { const int r = 4 * q + i;
                { const float qq = p1[r]; p1[r] = (1.0f - qq) * e1; e1 *= qq; }
                { const float qq = p0[r]; p0[r] = (1.0f - qq) * e0; e0 *= qq; } }
        }
        R *= run;
        tile_v_finish(wl, lane, pend);
        bf16x8 pa0, pa1, pa2, pa3; pack_p(p0, p1, pa0, pa1, pa2, pa3);
        pv_one<0>(o[0], vb, pa0, pa1, pa2, pa3); pv_one<1>(o[1], vb, pa0, pa1, pa2, pa3); pv_one<2>(o[2], vb, pa0, pa1, pa2, pa3); pv_one<3>(o[3], vb, pa0, pa1, pa2, pa3);
        if (__all(R < SB_STOP)) break;
    }
    if (has_next) strip_q_issue(P, nq_row0, nq_stride, nq_col, lane, qw); else strip_q_none(qw);
    asm volatile("" ::: "memory");
    asm volatile("s_nop 15\n\ts_nop 15" : "+v"(o[0]), "+v"(o[1]), "+v"(o[2]), "+v"(o[3]));
    { LAS unsigned char* const odst = wl + (4 * hi) * 272 + r32 * 2;
#pragma unroll
      for (int r = 0; r < 16; ++r)
#pragma unroll
        for (int d0 = 0; d0 < 4; ++d0) *(LAS bf16*)(odst + ((r & 3) + 8 * (r >> 2)) * 272 + d0 * 64) = (bf16)(pk2(o[d0][r], 0.f) & 0xffffu); }
    strip_o_store(OSB, t0, 1, SBW, h * HD, wl, lane);
}
__device__ __forceinline__ void dl_strip(const bf16* P, bf16* OB, float* ST, int h, int d, int rr, int i0, LAS unsigned char* wl, int lane_, v4u (&qw)[8], bool has_next, int nq_row0, int nq_stride, int nq_col) {
    int lane = lane_; asm volatile("" : "+v"(lane));
    const int r32 = lane & 31, hi = lane >> 5;
    bf16x8 qr[8];
    strip_q_finish(wl, lane, qw, qr);
    f32x16 o[4] = {}; float m = -1e30f, l = 0.f;
    const int vb = (int)(uintptr_t)wl + v_rd_base(lane);
    LAS float* al_l = (LAS float*)(wl + 17408);
    const int iq = i0 + r32;
    const int jlo = i0 >= 128 ? (i0 - 128) >> 6 : 0, jhi = (i0 + 31) >> 6;
    for (int jt = jlo; jt <= jhi; ++jt) {
        const int kb = jt * 64;
        f32x16 p0, p1;
        VPend pend; tile_qk(P, kb * d + rr, d, C_KDL + h * HD, C_VDL + h * HD, qr, wl, lane, p0, p1, pend);
        constexpr float C2 = ATT_SCALE * 1.4426950408889634f;
        float tmax = -3e38f;
#pragma unroll
        for (int r = 0; r < 16; ++r) {
            { const unsigned rel = (unsigned)(iq - (kb + crow(r, hi))); p0[r] = rel <= 128u ? p0[r] : -3e38f; tmax = fmaxf(tmax, p0[r]); }
            { const unsigned rel = (unsigned)(iq - (kb + 32 + crow(r, hi))); p1[r] = rel <= 128u ? p1[r] : -3e38f; tmax = fmaxf(tmax, p1[r]); }
        }
        tmax = fmaxf(tmax, __shfl_xor(tmax, 32));
        const float mn = fmaxf(m, tmax), alpha = __builtin_amdgcn_exp2f((m - mn) * C2), mnc = -mn * C2;
        float ps = 0.f;
#pragma unroll
        for (int r = 0; r < 16; ++r) { p0[r] = __builtin_amdgcn_exp2f(fmaf(p0[r], C2, mnc)); p1[r] = __builtin_amdgcn_exp2f(fmaf(p1[r], C2, mnc)); ps += p0[r] + p1[r]; }
        ps += __shfl_xor(ps, 32);
        l = l * alpha + ps; m = mn;
        if (jt > jlo && __any(alpha < 1.f)) { if (hi == 0) al_l[r32] = alpha; LDS_WAIT();
#pragma unroll
            for (int r = 0; r < 16; ++r) { const float a = al_l[crow(r, hi)];
#pragma unroll
                for (int d0 = 0; d0 < 4; ++d0) o[d0][r] *= a; }
            LDS_WAIT(); }
        tile_v_finish(wl, lane, pend);
        bf16x8 pa0, pa1, pa2, pa3; pack_p(p0, p1, pa0, pa1, pa2, pa3);
        pv_one<0>(o[0], vb, pa0, pa1, pa2, pa3); pv_one<1>(o[1], vb, pa0, pa1, pa2, pa3); pv_one<2>(o[2], vb, pa0, pa1, pa2, pa3); pv_one<3>(o[3], vb, pa0, pa1, pa2, pa3);
    }
    if (has_next) strip_q_issue(P, nq_row0, nq_stride, nq_col, lane, qw); else strip_q_none(qw);
    asm volatile("" ::: "memory");
    if (hi == 0) { al_l[r32] = l; *(f32x2*)(ST + ((size_t)(iq * d + rr) * NDLH + h) * 2) = (f32x2){m * ATT_SCALE, l}; }
    LDS_WAIT();
    { LAS unsigned char* const odst = wl + (4 * hi) * 272 + r32 * 2;
#pragma unroll
      for (int r = 0; r < 16; ++r) { const float rl = 1.0f / al_l[crow(r, hi)];
#pragma unroll
        for (int d0 = 0; d0 < 4; ++d0) *(LAS bf16*)(odst + ((r & 3) + 8 * (r >> 2)) * 272 + d0 * 64) = (bf16)(pk2(o[d0][r] * rl, 0.f) & 0xffffu); } }
    strip_o_store(OB, i0 * d + rr, d, DLW, h * HD, wl, lane);
    LDS_WAIT();
}
__device__ __forceinline__ void seg_norm_dl(const bf16* OB, const float* ST, int t, const float* gain, bf16* dst, int lane_) {
    int lane = lane_; asm volatile("" : "+v"(lane));
    float v[3][8]; float ss = 0.f;
#pragma unroll
    for (int i = 0; i < 3; ++i) { const int hd = 4 * i + (lane >> 4);
        f32x2 st[3]; float mx = -1e30f;
#pragma unroll
        for (int b = 0; b < 3; ++b) { st[b] = *(const f32x2*)(ST + (((size_t)b * SEQ + t) * NDLH + hd) * 2); mx = fmaxf(mx, st[b].x); }
        float w[3], den = 0.f;
#pragma unroll
        for (int b = 0; b < 3; ++b) { w[b] = __expf(st[b].x - mx) * st[b].y; den += w[b]; }
        const float rden = 1.0f / den;
#pragma unroll
        for (int e = 0; e < 8; ++e) v[i][e] = 0.f;
#pragma unroll
        for (int b = 0; b < 3; ++b) { const v4u a = *(const v4u*)(OB + ((size_t)b * SEQ + t) * DLW + 8 * lane + 512 * i); const float wb = w[b] * rden;
            v[i][0] += wb * bflo(a.x); v[i][1] += wb * bfhi(a.x); v[i][2] += wb * bflo(a.y); v[i][3] += wb * bfhi(a.y);
            v[i][4] += wb * bflo(a.z); v[i][5] += wb * bfhi(a.z); v[i][6] += wb * bflo(a.w); v[i][7] += wb * bfhi(a.w); }
#pragma unroll
        for (int e = 0; e < 8; ++e) ss += v[i][e] * v[i][e];
    }
    const float r = 1.0f / sqrtf(wave_sum(ss) * (1.0f / DLW) + RMS_EPS);
#pragma unroll
    for (int i = 0; i < 3; ++i) { const f32x4 g0 = *(const f32x4*)(gain + 8 * lane + 512 * i), g1 = *(const f32x4*)(gain + 8 * lane + 512 * i + 4);
        v4u o; o.x = pk2(v[i][0] * r * g0.x, v[i][1] * r * g0.y); o.y = pk2(v[i][2] * r * g0.z, v[i][3] * r * g0.w);
        o.z = pk2(v[i][4] * r * g1.x, v[i][5] * r * g1.y); o.w = pk2(v[i][6] * r * g1.z, v[i][7] * r * g1.w);
        *(v4u*)(dst + 8 * lane + 512 * i) = o; }
}


__device__ __forceinline__ void gains3_to_lds(const float* g_sb, const float* g_dl, const float* g_ssm, LAS float* gl, int lane_, int wid) {
    int lane = lane_; asm volatile("" : "+v"(lane));
    __syncthreads();
#pragma unroll
    for (int q = 0; q < 2; ++q) { const int i = (q * NWAVES + wid) * 64 + lane;
        const f32x4 v = i < 384 ? ((const f32x4*)g_sb)[i] : (i < 768 ? ((const f32x4*)g_dl)[i - 384] : ((const f32x4*)g_ssm)[i - 768]);
        ((LAS f32x4*)gl)[i] = v; }
    LDS_WAIT();
    __syncthreads();
}
__device__ __forceinline__ float ssq8(const v4u& a) {
    return (bflo(a.x) * bflo(a.x) + bfhi(a.x) * bfhi(a.x)) + (bflo(a.y) * bflo(a.y) + bfhi(a.y) * bfhi(a.y)) + (bflo(a.z) * bflo(a.z) + bfhi(a.z) * bfhi(a.z)) + (bflo(a.w) * bflo(a.w) + bfhi(a.w) * bfhi(a.w));
}
__device__ __forceinline__ v4u scale8(const v4u& a, float r, const f32x4& g0, const f32x4& g1) {
    v4u o; o.x = pk2(bflo(a.x) * r * g0.x, bfhi(a.x) * r * g0.y); o.y = pk2(bflo(a.y) * r * g0.z, bfhi(a.y) * r * g0.w);
    o.z = pk2(bflo(a.z) * r * g1.x, bfhi(a.z) * r * g1.y); o.w = pk2(bflo(a.w) * r * g1.z, bfhi(a.w) * r * g1.w); return o;
}
template <bool AB, bool SSM>
__device__ __forceinline__ void mix_row(const bf16* OSBp, const bf16* ODLp, const float* ST, const bf16* OSSMp, int t, const LAS float* gl, bf16* MIXp, int lane_) {
    int lane = lane_; asm volatile("" : "+v"(lane));
    v4u a_sb[3], a_dl[3][3], a_ss[2]; f32x2 st[3][3];
    if (AB) {
#pragma unroll
        for (int i = 0; i < 3; ++i) a_sb[i] = *(const v4u*)(OSBp + (size_t)t * SBW + 8 * lane + 512 * i);
#pragma unroll
        for (int i = 0; i < 3; ++i) { const int hd = 4 * i + (lane >> 4);
#pragma unroll
            for (int b = 0; b < 3; ++b) { st[i][b] = *(const f32x2*)(ST + (((size_t)b * SEQ + t) * NDLH + hd) * 2); a_dl[i][b] = *(const v4u*)(ODLp + ((size_t)b * SEQ + t) * DLW + 8 * lane + 512 * i); } }
    }
    if (SSM) {
#pragma unroll
        for (int i = 0; i < 2; ++i) a_ss[i] = *(const v4u*)(OSSMp + (size_t)t * SSMC + 8 * lane + 512 * i);
    }
    asm volatile("" ::: "memory");
    bf16* dst = MIXp + (size_t)t * DM;
    if (AB) {
        {
            float ss = 0.f;
#pragma unroll
            for (int i = 0; i < 3; ++i) ss += ssq8(a_sb[i]);
            const float r = 1.0f / sqrtf(wave_sum(ss) * (1.0f / SBW) + RMS_EPS);
#pragma unroll
            for (int i = 0; i < 3; ++i) { const f32x4 g0 = *(const LAS f32x4*)(gl + 8 * lane + 512 * i), g1 = *(const LAS f32x4*)(gl + 8 * lane + 512 * i + 4);
                *(v4u*)(dst + 8 * lane + 512 * i) = scale8(a_sb[i], r, g0, g1); }
        }
        {
            float v[3][8]; float ss = 0.f;
#pragma unroll
            for (int i = 0; i < 3; ++i) {
                float mx = -1e30f;
#pragma unroll
                for (int b = 0; b < 3; ++b) mx = fmaxf(mx, st[i][b].x);
                float w[3], den = 0.f;
#pragma unroll
                for (int b = 0; b < 3; ++b) { w[b] = __expf(st[i][b].x - mx) * st[i][b].y; den += w[b]; }
                const float rden = 1.0f / den;
#pragma unroll
                for (int e = 0; e < 8; ++e) v[i][e] = 0.f;
#pragma unroll
                for (int b = 0; b < 3; ++b) { const v4u a = a_dl[i][b]; const float wb = w[b] * rden;
                    v[i][0] += wb * bflo(a.x); v[i][1] += wb * bfhi(a.x); v[i][2] += wb * bflo(a.y); v[i][3] += wb * bfhi(a.y);
                    v[i][4] += wb * bflo(a.z); v[i][5] += wb * bfhi(a.z); v[i][6] += wb * bflo(a.w); v[i][7] += wb * bfhi(a.w); }
#pragma unroll
                for (int e = 0; e < 8; ++e) ss += v[i][e] * v[i][e];
            }
            const float r = 1.0f / sqrtf(wave_sum(ss) * (1.0f / DLW) + RMS_EPS);
#pragma unroll
            for (int i = 0; i < 3; ++i) { const f32x4 g0 = *(const LAS f32x4*)(gl + SBW + 8 * lane + 512 * i), g1 = *(const LAS f32x4*)(gl + SBW + 8 * lane + 512 * i + 4);
                v4u o; o.x = pk2(v[i][0] * r * g0.x, v[i][1] * r * g0.y); o.y = pk2(v[i][2] * r * g0.z, v[i][3] * r * g0.w);
                o.z = pk2(v[i][4] * r * g1.x, v[i][5] * r * g1.y); o.w = pk2(v[i][6] * r * g1.z, v[i][7] * r * g1.w);
                *(v4u*)(dst + SBW + 8 * lane + 512 * i) = o; }
        }
    }
    if (SSM) {
        float ss = 0.f;
#pragma unroll
        for (int i = 0; i < 2; ++i) ss += ssq8(a_ss[i]);
        const float r = 1.0f / sqrtf(wave_sum(ss) * (1.0f / SSMC) + RMS_EPS);
#pragma unroll
        for (int i = 0; i < 2; ++i) { const f32x4 g0 = *(const LAS f32x4*)(gl + SBW + DLW + 8 * lane + 512 * i), g1 = *(const LAS f32x4*)(gl + SBW + DLW + 8 * lane + 512 * i + 4);
            *(v4u*)(dst + SBW + DLW + 8 * lane + 512 * i) = scale8(a_ss[i], r, g0, g1); }
    }
}

struct Args { const float* in[23]; float* out; unsigned char* ws; int s_lo, s_hi; };

constexpr int I_IN = 64 * 160, I_GLU = 16 * 16, I_OUT = 64 * 64, I_G = 64 * 172, I_D = 172 * 64, I_L = I_IN + I_GLU + I_OUT + 2 * I_G + I_D;
__device__ __forceinline__ ConvItem conv_decode(const Args& args, unsigned char* ws, int item) {
    const int l = item / I_L; int r = item % I_L; ConvItem c;
    unsigned char* const WL = ws + WS_W + (size_t)l * WL_BYTES;
    if (r < I_IN) { c.W = args.in[5] + (size_t)l * DM * INW; c.K = DM; c.N = INW; c.WT = (bf16*)(WL + WO_IN); c.k0 = 64 * (r / 160); c.n0 = 64 * (r % 160); c.orow0 = c.n0; return c; } r -= I_IN;
    if (r < I_GLU) { c.W = args.in[17] + (size_t)l * SSMC * SSMC; c.K = SSMC; c.N = SSMC; c.WT = (bf16*)(WL + WO_GLU); c.k0 = 64 * (r / 16); c.n0 = 64 * (r % 16); c.orow0 = c.n0; return c; } r -= I_GLU;
    if (r < I_OUT) { c.W = args.in[19] + (size_t)l * DM * DM; c.K = DM; c.N = DM; c.WT = (bf16*)(WL + WO_OUT); c.k0 = 64 * (r / 64); c.n0 = 64 * (r % 64); c.orow0 = c.n0; return c; } r -= I_OUT;
    if (r < 2 * I_G) { const int up = r >= I_G; if (up) r -= I_G; c.W = args.in[up ? 21 : 20] + (size_t)l * DM * FFN; c.K = DM; c.N = FFN; c.WT = (bf16*)(WL + WO_GU); c.k0 = 64 * (r / 172); c.n0 = 64 * (r % 172);
        c.orow0 = 256 * (c.n0 / 128) + (c.n0 % 128) + (up ? 128 : 0); return c; } r -= 2 * I_G;
    c.W = args.in[22] + (size_t)l * FFN * DM; c.K = FFN; c.N = DM; c.WT = (bf16*)(WL + WO_DN); c.k0 = 64 * (r / 64); c.n0 = 64 * (r % 64); c.orow0 = c.n0; return c;
}
__device__ __forceinline__ void conv_item(const Args& args, unsigned char* ws, int l, int r, LAS float* scr, int lane) {
    bf16* const WL = (bf16*)(ws + WS_W + (size_t)l * WL_BYTES);
    if (r < I_IN) { tr_tile(args.in[5] + (size_t)l * DM * INW, DM, INW, (bf16*)((unsigned char*)WL + WO_IN), 64 * (r / 160), 64 * (r % 160), 64 * (r % 160), scr, lane); return; } r -= I_IN;
    if (r < I_GLU) { tr_tile(args.in[17] + (size_t)l * SSMC * SSMC, SSMC, SSMC, (bf16*)((unsigned char*)WL + WO_GLU), 64 * (r / 16), 64 * (r % 16), 64 * (r % 16), scr, lane); return; } r -= I_GLU;
    if (r < I_OUT) { tr_tile(args.in[19] + (size_t)l * DM * DM, DM, DM, (bf16*)((unsigned char*)WL + WO_OUT), 64 * (r / 64), 64 * (r % 64), 64 * (r % 64), scr, lane); return; } r -= I_OUT;
    if (r < 2 * I_G) { const int up = r >= I_G; if (up) r -= I_G; const int n0 = 64 * (r % 172);
        tr_tile(args.in[up ? 21 : 20] + (size_t)l * DM * FFN, DM, FFN, (bf16*)((unsigned char*)WL + WO_GU), 64 * (r / 172), n0, 256 * (n0 / 128) + (n0 % 128) + (up ? 128 : 0), scr, lane); return; } r -= 2 * I_G;
    tr_tile(args.in[22] + (size_t)l * FFN * DM, FFN, DM, (bf16*)((unsigned char*)WL + WO_DN), 64 * (r / 64), 64 * (r % 64), 64 * (r % 64), scr, lane);
}
__global__ void __launch_bounds__(NWAVES * 64, 2) hybrid_fwd(Args args) {
    extern __shared__ __attribute__((aligned(16))) unsigned char lds_raw[];
    LAS unsigned char* const lds = (LAS unsigned char*)lds_raw;
    volatile LAS unsigned* const MISC = (volatile LAS unsigned*)(lds + MISC_OFF);
    const int wave = __builtin_amdgcn_readfirstlane((int)threadIdx.x >> 6);
    const int G = gridDim.x, gw = blockIdx.x * NWAVES + wave, ngw = G * NWAVES;
    unsigned char* const ws = args.ws;
    gu32* const ctl = (gu32*)(ws + WS_CTL);
    LAS unsigned char* const wl = lds + wave * WAVE_LDS;
    for (int u = threadIdx.x; u < (LDS_BYTES - LDSCTL_OFF) / 4; u += NWAVES * 64) ((LAS unsigned*)(lds + LDSCTL_OFF))[u] = 0u;
    __syncthreads();
    const int s_lo = args.s_lo, s_hi = args.s_hi;
    XcdBarrier bar; bar.bar = (unsigned*)(ctl + CW_BAR); bar.x = 0; bar.st = nullptr; bar.w = wave;
    if (s_hi - s_lo > 1) bar = xcd_barrier_post((unsigned*)(ctl + CW_BAR), MISC + 8, wave);
#ifndef ROW_PF6
#define ROW_PF6 true
#endif
#ifndef ROW_PF9A
#define ROW_PF9A true
#endif
#ifndef ROW_PF9B
#define ROW_PF9B false
#endif
#ifndef ROW_PF0
#define ROW_PF0 false
#endif
#ifndef RES_F32
#define RES_F32 0
#endif
#ifndef STEP_MASK
#define STEP_MASK 0x7ff
#endif
#define EN(k) (((STEP_MASK) >> (k)) & 1)
#ifndef REP_MASK
#define REP_MASK 0
#endif
#define NREP(k) ((((REP_MASK) >> (k)) & 1) ? 2 : 1)
#ifndef MIX_NAIVE
#define MIX_NAIVE 0
#endif
#ifndef PROBE_P0
#define PROBE_P0 1
#endif
#ifndef PROBE_GU
#define PROBE_GU 0
#endif
#ifndef PROBE_S2
#define PROBE_S2 1
#endif
#ifndef PROBE_TD
#define PROBE_TD 1
#endif
#ifndef PROBE_TF
#define PROBE_TF 1
#endif
#ifndef EXP_DELAY
#define EXP_DELAY 0
#endif
#ifndef CONV_DEFER
#define CONV_DEFER 0
#endif
#ifndef CONV_PER_UNIT
#define CONV_PER_UNIT 6
#endif
#ifndef PROBE_GEMM
#define PROBE_GEMM 0
#endif
#ifndef TD_EARLY
#define TD_EARLY 8192
#endif
#ifndef CONV_PIPE
#define CONV_PIPE 1
#endif
#ifndef XN_PF
#define XN_PF true
#endif
#ifndef STAMP_MODE
#define STAMP_MODE 0
#endif
#ifndef STAMP_SUB
#define STAMP_SUB 0
#endif
#ifndef STAMP_GAIN
#define STAMP_GAIN 4
#endif
#ifndef STAMP_MASK
#define STAMP_MASK 0
#endif
#ifndef CONV_REVERSE
#define CONV_REVERSE 0
#endif
#ifndef MIX_STAGGER
#define MIX_STAGGER 0
#endif
#ifndef MIX_ITEMS
#define MIX_ITEMS 0
#endif
#ifndef TAIL_ITEMS
#define TAIL_ITEMS 0
#endif
#ifndef PROBE_SB
#define PROBE_SB 1
#endif
#ifndef PROBE_DL
#define PROBE_DL 1
#endif
#ifndef PROBE_S1
#define PROBE_S1 1
#endif
#define RUN(s) (s_lo <= (s) && (s) < s_hi)
#ifndef PROBE_BAR
#define PROBE_BAR 1
#endif
#if STAMP_MODE
    unsigned long long st_prev = wall_clock64(), st_acc = 0ull;
#define SEAM(s) do { __builtin_amdgcn_s_setprio(0); if (RUN(s) && RUN((s) + 1)) { const unsigned long long ta_ = wall_clock64(); xcd_barrier(bar); const unsigned long long te_ = wall_clock64(); \
        if (STAMP_MODE < 3 && (((STAMP_MASK) >> (s)) & 1)) st_acc += te_ - (STAMP_MODE == 2 ? ta_ : st_prev); st_prev = te_; } } while (0)
#else
#define SEAM(s) do { __builtin_amdgcn_s_setprio(0); if (RUN(s) && RUN((s) + 1)) { xcd_barrier(bar); if (PROBE_BAR > 1) xcd_barrier(bar); } } while (0)
#endif

    const float* const x_in = args.in[0];
    bf16* const XN = (bf16*)(ws + WS_XN); bf16* const PROJ = (bf16*)(ws + WS_PROJ); bf16* const OSB = (bf16*)(ws + WS_OSB); bf16* const HB = (bf16*)(ws + WS_H);
    bf16* const MIX = (bf16*)(ws + WS_MIX); bf16* const FB = (bf16*)(ws + WS_F);
#if RES_F32
    typedef float res_t; res_t* const X1 = (res_t*)(ws + WS_X1); res_t* const XL = args.out;
#else
    typedef bf16 res_t; res_t* const X1 = (res_t*)(ws + WS_X1); res_t* const XL = (res_t*)(ws + WS_X1 + 64 * MiB);
#endif
    bf16* const ODL = (bf16*)(ws + WS_ODL);
    bf16* const GB = (bf16*)(ws + WS_G); bf16* const OSSM = (bf16*)(ws + WS_OSSM); float* const XE = (float*)(ws + WS_XE); float* const STAT = (float*)(ws + WS_STAT);

    if (EN(0) && RUN(0)) { const int ln = fresh_lane();
        LAS float* scr = (LAS float*)wl;
#if STAMP_MODE == 5
        const unsigned long long tp0_ = wall_clock64();
#endif
        const int ntail = (G == 256) ? TAIL_ITEMS + MIX_ITEMS : 0;
        const int nconv = DEPTH * I_L - ntail;
#define CONV_MAP(i) (CONV_REVERSE && ntail == 0 ? nconv - 1 - (i) : ((i) < I_L ? (i) : (i) + ntail))
#if CONV_PIPE
        {
            f32x4 va[16], vb[16]; int it0 = gw; const int nit = PROBE_P0 * nconv;
            ConvItem ca = conv_decode(args, ws, CONV_MAP((it0 < nit ? it0 : 0) % nconv)), cb = ca;
            if (it0 < nit) tr_load(ca, ln, va);
            while (it0 < nit) {
                const int it1 = it0 + ngw; if (it1 < nit) { cb = conv_decode(args, ws, CONV_MAP(it1 % nconv)); tr_load(cb, ln, vb); }
                tr_store(ca, scr, ln, va);
                if (it1 >= nit) break;
                const int it2 = it1 + ngw; if (it2 < nit) { ca = conv_decode(args, ws, CONV_MAP(it2 % nconv)); tr_load(ca, ln, va); }
                tr_store(cb, scr, ln, vb);
                it0 = it2;
            }
        }
#else
        for (int it0 = gw; it0 < PROBE_P0 * nconv; it0 += ngw) { const int it = CONV_MAP(it0 % nconv); conv_item(args, ws, it / I_L, it % I_L, scr, ln); }
#endif
#undef CONV_MAP
#if STAMP_MODE == 5
        asm volatile("s_waitcnt vmcnt(0)" ::: "memory"); const unsigned long long tp1_ = wall_clock64(); if (STAMP_SUB == 1) st_acc += tp1_ - tp0_;
#endif
        for (int m0 = gw; m0 < PROBE_P0 * SEQ; m0 += ngw) { const int m = m0 % SEQ; row_op(x_in + (size_t)m * DM, (const bf16*)nullptr, (const float*)nullptr, (float*)nullptr, args.in[1], XN + (size_t)m * DM, ln); }
#if STAMP_MODE == 5
        { asm volatile("s_waitcnt vmcnt(0)" ::: "memory"); const unsigned long long tp2_ = wall_clock64(); if (STAMP_SUB == 2) st_acc += tp2_ - tp1_; }
#endif
    }
    SEAM(0);

    for (int l = 0; l < DEPTH; ++l) {
        const int sb = 1 + STEPS_PER_LAYER * l;
        const unsigned char* const WL = ws + WS_W + (size_t)l * WL_BYTES;
        if (EN(1) && RUN(sb + 0)) {
            pg8::Gemm g{XN, (const bf16*)(WL + WO_IN), SEQ, INW, DM}; pg8::StaticOrder S; S.init(SEQ, INW, G, (int)blockIdx.x);
            pg8::EpiStoreBf16 E{PROJ, INW};
            pg8::gemm_phase<pg8::EpiStoreBf16, pg8::StaticOrder, true, true>(lds, g, S, E, wave);
#if PROBE_GEMM == 1 || PROBE_GEMM == 9
            pg8::gemm_phase<pg8::EpiStoreBf16, pg8::StaticOrder, true, true>(lds, g, S, E, wave);
#endif
        }
        SEAM(sb + 0);
        if (EN(2) && RUN(sb + 1)) { const int ln = fresh_lane();
            if (wave >= 4) __builtin_amdgcn_s_setprio(1);
            const int gwx = (G % 8 == 0) ? (((int)blockIdx.x % 8) * (G / 8) + (int)blockIdx.x / 8) * NWAVES + wave : gw;
            int tc = gw;
#define CONV_SOME(n) do { if (MIX_ITEMS > 0 && G == 256 && l == 0) for (int q_ = 0; q_ < (n) && tc < MIX_ITEMS; ++q_, tc += ngw) conv_item(args, ws, 1, TAIL_ITEMS + tc, (LAS float*)wl, ln); } while (0)
#if EXP_OLDSSM & 1
            SsmWOld wo{args.in[9] + l * NGRP * NST, args.in[10] + l * NGRP * NST, args.in[11] + l * NGRP, args.in[12] + (size_t)l * NGRP * NST * SGRP, args.in[13] + (size_t)l * NGRP * NST * SGRP,
                   args.in[14] + (size_t)l * NGRP * SGRP * NST, args.in[15] + (size_t)l * NGRP * SGRP * NST, args.in[16] + l * SSMC};
            for (int u = gw; u < SSM_NCH * NGRP; u += ngw) ssm_pass1_old(PROJ, wo, XE, u % NGRP, u / NGRP, wl, ln);
#else
            const SsmW w{args.in[9] + l * NGRP * NST, args.in[10] + l * NGRP * NST, args.in[11] + l * NGRP, args.in[12] + (size_t)l * NGRP * NST * SGRP, args.in[13] + (size_t)l * NGRP * NST * SGRP,
                         args.in[14] + (size_t)l * NGRP * SGRP * NST, args.in[15] + (size_t)l * NGRP * SGRP * NST, args.in[16] + l * SSMC};
#if MIX_STAGGER
#pragma clang loop unroll(disable)
            for (int ph = 0; ph < 2; ++ph) {
            if ((ph == 0) == (((wave >> 2) & 1) == 1))
#endif
#if STAMP_MODE == 3
            const unsigned long long ts0_ = wall_clock64();
#endif
            for (int u = gwx; u < PROBE_S1 * SSM_NCH * NGRP; u += ngw) { const int v = u % (SSM_NCH * NGRP); ssm_unit<false>(PROJ, w, XE, nullptr, v % NGRP, v / NGRP, wl, ln); }
#if STAMP_MODE == 3
            const unsigned long long ts1_ = wall_clock64(); if (STAMP_SUB == 1) st_acc += ts1_ - ts0_;
#endif
#if MIX_STAGGER
            else {
#endif
#endif
#if MIX_NAIVE
            for (int u = gw; u < PROBE_SB * NSBH * SEQ; u += ngw) { const int v = u % (NSBH * SEQ); sb_naive(PROJ, OSB, v / SEQ, v % SEQ, ln); }
            for (int u = gw; u < PROBE_DL * NDLH * SEQ; u += ngw) { const int v = u % (NDLH * SEQ); dl_naive(PROJ, ODL, v / SEQ, v % SEQ, ln); }
#else
            {
                constexpr int NSB_ = NSBH * 256, NDL_ = 3 * NDLH * 256;
#define DL_DESC(v_, b_, hh_, d_, rr_, i0_) const int b_ = (v_) / (NDLH * 256), hh_ = ((v_) % (NDLH * 256)) >> 8, d_ = b_ == 0 ? 1 : (b_ == 1 ? 4 : 16), rr_ = (((v_) % (NDLH * 256)) & 255) / (256 / d_), i0_ = 32 * ((((v_) % (NDLH * 256)) & 255) % (256 / d_))
                int usb = gwx, udl = ngw - 1 - gwx;
                v4u qw[8];
                if (usb < NSB_) strip_q_issue(PROJ, 32 * (usb & 255), 1, C_QSB + (usb >> 8) * HD, ln, qw);
                else if (udl < NDL_) { DL_DESC(udl, b, hh, d, rr, i0); strip_q_issue(PROJ, i0 * d + rr, d, C_QDL + hh * HD, ln, qw); }
                else strip_q_none(qw);
                for (; usb < NSB_; usb += ngw) { const int un = usb + ngw;
                    bool hn; int nr0, nst, nc;
                    if (un < NSB_) { hn = true; nr0 = 32 * (un & 255); nst = 1; nc = C_QSB + (un >> 8) * HD; }
                    else if (udl < NDL_) { DL_DESC(udl, b, hh, d, rr, i0); hn = true; nr0 = i0 * d + rr; nst = d; nc = C_QDL + hh * HD; }
                    else { hn = false; nr0 = 0; nst = 1; nc = 0; }
                    sb_strip(PROJ, OSB, usb >> 8, 32 * (usb & 255), wl, ln, qw, hn, nr0, nst, nc); }
                for (; udl < NDL_; udl += ngw) { DL_DESC(udl, b, hh, d, rr, i0); const int un = udl + ngw;
                    bool hn = un < NDL_; int nr0 = 0, nst = 1, nc = 0;
                    if (hn) { DL_DESC(un, b2, hh2, d2, rr2, i02); nr0 = i02 * d2 + rr2; nst = d2; nc = C_QDL + hh2 * HD; }
                    dl_strip(PROJ, ODL + (size_t)b * SEQ * DLW, STAT + (size_t)b * SEQ * NDLH * 2, hh, d, rr, i0, wl, ln, qw, hn, nr0, nst, nc); }
#undef DL_DESC
            }
#endif
#if MIX_STAGGER && !(EXP_OLDSSM & 1)
            } }
#endif
#undef CONV_SOME
            __builtin_amdgcn_s_setprio(0);
        }
        SEAM(sb + 1);
        if (EN(3) && RUN(sb + 2)) { const int ln = fresh_lane();
            if (wave >= 4) __builtin_amdgcn_s_setprio(1);
            const int gwx = (G % 8 == 0) ? (((int)blockIdx.x % 8) * (G / 8) + (int)blockIdx.x / 8) * NWAVES + wave : gw;
#if EXP_DELAY
            for (int i = 0; i < 40; ++i) __builtin_amdgcn_s_sleep(127);
#endif
#if EXP_OLDSSM & 2
            SsmWOld wo{args.in[9] + l * NGRP * NST, args.in[10] + l * NGRP * NST, args.in[11] + l * NGRP, args.in[12] + (size_t)l * NGRP * NST * SGRP, args.in[13] + (size_t)l * NGRP * NST * SGRP,
                   args.in[14] + (size_t)l * NGRP * SGRP * NST, args.in[15] + (size_t)l * NGRP * SGRP * NST, args.in[16] + l * SSMC};
            for (int u = gw; u < SSM_NCH * NGRP; u += ngw) ssm_pass2_old(PROJ, wo, XE, GB, u % NGRP, u / NGRP, wl, ln);
#else
            const SsmW w{args.in[9] + l * NGRP * NST, args.in[10] + l * NGRP * NST, args.in[11] + l * NGRP, args.in[12] + (size_t)l * NGRP * NST * SGRP, args.in[13] + (size_t)l * NGRP * NST * SGRP,
                         args.in[14] + (size_t)l * NGRP * SGRP * NST, args.in[15] + (size_t)l * NGRP * SGRP * NST, args.in[16] + l * SSMC};
            for (int u = gwx; u < PROBE_S2 * SSM_NCH * NGRP; u += ngw) { const int v = u % (SSM_NCH * NGRP), c = v / NGRP;
                ssm_unit<true>(PROJ, w, XE, GB, v % NGRP, c < SSM_NCH / 2 ? c : 3 * SSM_NCH / 2 - 1 - c, wl, ln); }
#endif
            __builtin_amdgcn_s_setprio(0);
        }
        SEAM(sb + 2);
        if (EN(4) && RUN(sb + 3)) {
#if EXP_DELAY
            for (int i = 0; i < 40; ++i) __builtin_amdgcn_s_sleep(127);
#endif
            pg8::Gemm g{GB, (const bf16*)(WL + WO_GLU), SEQ, SSMC, SSMC}; pg8::StaticOrder S; S.init(SEQ, SSMC, G, (int)blockIdx.x);
            pg8::EpiGlu E{GB, OSSM, SSMC, args.in[18] + l * SSMC};
            pg8::gemm_phase<pg8::EpiGlu, pg8::StaticOrder, true, true>(lds, g, S, E, wave);
            const int nun = (SEQ / 256) * (SSMC / 256);
            if ((int)blockIdx.x >= nun && G > nun) { const int ln = fresh_lane(); const int gw2 = ((int)blockIdx.x - nun) * NWAVES + wave, ngw2 = (G - nun) * NWAVES;
                if (wave >= 4) __builtin_amdgcn_s_setprio(1);
                gains3_to_lds(args.in[6] + l * SBW, args.in[7] + l * DLW, args.in[8] + l * SSMC, (LAS float*)lds, ln, wave);
                for (int t = gw2; t < TD_EARLY; t += ngw2) mix_row<true, false>(OSB, ODL, STAT, OSSM, t, (const LAS float*)lds, MIX, ln); }
        }
        SEAM(sb + 3);
        if (EN(5) && RUN(sb + 4)) { const int ln = fresh_lane();
            if (wave >= 4) __builtin_amdgcn_s_setprio(1);
            const int t_early = (G > (SEQ / 256) * (SSMC / 256)) ? TD_EARLY : 0;
            gains3_to_lds(args.in[6] + l * SBW, args.in[7] + l * DLW, args.in[8] + l * SSMC, (LAS float*)lds, ln, wave);
            for (int t0 = gw; t0 < PROBE_TD * SEQ; t0 += ngw) { const int t = t0 % SEQ;
                if (t >= t_early) mix_row<true, true>(OSB, ODL, STAT, OSSM, t, (const LAS float*)lds, MIX, ln);
                else mix_row<false, true>(OSB, ODL, STAT, OSSM, t, (const LAS float*)lds, MIX, ln);
            }
        }
        SEAM(sb + 4);
        if (EN(6) && RUN(sb + 5)) {
            pg8::Gemm g{MIX, (const bf16*)(WL + WO_OUT), SEQ, DM, DM}; pg8::StaticOrder S; S.init(SEQ, DM, G, (int)blockIdx.x);
            pg8::EpiStoreBf16 E{FB, DM};
            pg8::gemm_phase<pg8::EpiStoreBf16, pg8::StaticOrder, true, true>(lds, g, S, E, wave);
#if PROBE_GEMM == 2 || PROBE_GEMM == 9
            pg8::gemm_phase<pg8::EpiStoreBf16, pg8::StaticOrder, true, true>(lds, g, S, E, wave);
#endif
        }
        SEAM(sb + 5);
        if (EN(7) && RUN(sb + 6)) { const int ln = fresh_lane();
            if (wave >= 4) __builtin_amdgcn_s_setprio(1);
            gains_to_lds(args.in[2] + l * DM, args.in[3] + l * DM, (LAS float*)lds, ln, wave);
            if (l == 0) row_phase<float, res_t, true, ROW_PF0>(x_in, FB, (const LAS float*)lds, X1, XN, gw, ngw, PROBE_TF * SEQ, ln);
            else row_phase<res_t, res_t, true, ROW_PF6>(XL, FB, (const LAS float*)lds, X1, XN, gw, ngw, PROBE_TF * SEQ, ln);
        }
        SEAM(sb + 6);
        if (EN(8) && RUN(sb + 7)) {
            pg8::Gemm g{XN, (const bf16*)(WL + WO_GU), SEQ, GUW, DM}; pg8::StaticOrder S; S.init(SEQ, GUW, G, (int)blockIdx.x);
            pg8::EpiSwiGLU E{HB, FFN};
            pg8::gemm_phase<pg8::EpiSwiGLU, pg8::StaticOrder, true, true>(lds, g, S, E, wave);
            if (l == 0 && G == 256 && (int)blockIdx.x >= 192) { const int ln = fresh_lane(); const int gw2 = ((int)blockIdx.x - 192) * NWAVES + wave;
                for (int it = gw2; it < TAIL_ITEMS; it += 64 * NWAVES) conv_item(args, ws, 1, it, (LAS float*)wl, ln); }
#if PROBE_GU || PROBE_GEMM == 9
            pg8::gemm_phase<pg8::EpiSwiGLU, pg8::StaticOrder, true, true>(lds, g, S, E, wave);
#endif
        }
        SEAM(sb + 7);
        if (EN(9) && RUN(sb + 8)) {
            pg8::Gemm g{HB, (const bf16*)(WL + WO_DN), SEQ, DM, FFN}; pg8::StaticOrder S; S.init(SEQ, DM, G, (int)blockIdx.x);
            pg8::EpiStoreBf16 E{FB, DM};
            pg8::gemm_phase<pg8::EpiStoreBf16, pg8::StaticOrder, true, true>(lds, g, S, E, wave);
#if PROBE_GEMM == 3 || PROBE_GEMM == 9
            pg8::gemm_phase<pg8::EpiStoreBf16, pg8::StaticOrder, true, true>(lds, g, S, E, wave);
#endif
        }
        SEAM(sb + 8);
        if (EN(10) && RUN(sb + 9)) { const int ln = fresh_lane();
            if (wave >= 4) __builtin_amdgcn_s_setprio(1);
            const bool more = l + 1 < DEPTH;
            gains_to_lds(args.in[4] + l * DM, more ? args.in[1] + (l + 1) * DM : nullptr, (LAS float*)lds, ln, wave);
            if (more) row_phase<res_t, res_t, true, ROW_PF9A>(X1, FB, (const LAS float*)lds, XL, XN, gw, ngw, PROBE_TF * SEQ, ln);
            else row_phase<res_t, float, false, ROW_PF9B>(X1, FB, (const LAS float*)lds, args.out, (bf16*)nullptr, gw, ngw, PROBE_TF * SEQ, ln);
        }
        SEAM(sb + 9);
    }
#if STAMP_MODE
    { asm volatile("s_waitcnt vmcnt(0)" ::: "memory"); __syncthreads();
      const unsigned long long te_ = wall_clock64(); if (STAMP_MODE == 1 && (((STAMP_MASK) >> (NSTEPS - 1)) & 1)) st_acc += te_ - st_prev;
      const unsigned long long until_ = te_ + (unsigned long long)STAMP_GAIN * st_acc;
      while (wall_clock64() < until_) __builtin_amdgcn_s_sleep(64); }
#endif
#undef RUN
#undef SEAM
}

extern "C" void kernel_launch(void* const* d_in, const int* in_sizes, int n_in, void* d_out, int out_size, void* d_ws, size_t ws_size, hipStream_t stream) {
    static int grid = 0;
    if (grid == 0) {
        if (n_in != 23 || in_sizes[0] != SEQ * DM || out_size != SEQ * DM || ws_size < WS_END) { fprintf(stderr, "kernel_launch: unexpected shapes (n_in %d, in0 %d, out %d, ws %zu < %zu); nothing launched\n", n_in, n_in > 0 ? in_sizes[0] : -1, out_size, ws_size, (size_t)WS_END); grid = -1; return; }
        int dev = 0, cus = 0, per_cu = 0;
        if (hipGetDevice(&dev) != hipSuccess || hipDeviceGetAttribute(&cus, hipDeviceAttributeMultiprocessorCount, dev) != hipSuccess) { fprintf(stderr, "kernel_launch: device query failed\n"); grid = -1; return; }
        if (hipFuncSetAttribute((const void*)hybrid_fwd, hipFuncAttributeMaxDynamicSharedMemorySize, LDS_BYTES) != hipSuccess) { fprintf(stderr, "kernel_launch: hipFuncSetAttribute failed\n"); grid = -1; return; }
        if (hipOccupancyMaxActiveBlocksPerMultiprocessor(&per_cu, (const void*)hybrid_fwd, NWAVES * 64, LDS_BYTES) != hipSuccess || per_cu < 1)
            fprintf(stderr, "kernel_launch: note: occupancy query reports %d workgroups per CU\n", per_cu);
        (void)hipGetLastError();
        grid = cus;
    }
    if (grid < 0) return;
    if (hipMemsetAsync((char*)d_ws + WS_CTL, 0, CTL_ZERO_BYTES, stream) != hipSuccess) { fprintf(stderr, "kernel_launch: hipMemsetAsync failed\n"); return; }
    Args a{};
    for (int i = 0; i < 23; ++i) a.in[i] = (const float*)d_in[i];
    a.out = (float*)d_out; a.ws = (unsigned char*)d_ws;
#if MK_SINGLE
    a.s_lo = 0; a.s_hi = NSTEPS;
    hipLaunchKernelGGL(hybrid_fwd, dim3(grid), dim3(NWAVES * 64), LDS_BYTES, stream, a);
#else
    for (int s = 0; s < NSTEPS; ++s) { a.s_lo = s; a.s_hi = s + 1; hipLaunchKernelGGL(hybrid_fwd, dim3(grid), dim3(NWAVES * 64), LDS_BYTES, stream, a); }
#endif
    const hipError_t le = hipPeekAtLastError();
    if (le != hipSuccess) fprintf(stderr, "kernel_launch: launch failed: %s\n", hipGetErrorName(le));
}
```
